# Optimizing an MI355X kernel written in HIP

```python
import jax, jax.numpy as jnp
from jax import lax
import numpy as np

D_MODEL = 1024
BATCH = 16
SEQ = 2048
DEPTH = 1

CTX_LEN = 256
GRID_W = 64
POOL_WIDTH = D_MODEL
POOL_GROUPS = 4
POOL_GROUP_DIM = POOL_WIDTH // POOL_GROUPS
POOL_WINDOWS = (2, 4, 8, 16)
N_HEADS = 16
QK_NOPE = 128
QK_ROPE = 64
V_DIM = 128
Q_LORA = 256
KV_LORA = 128
MLA_WIDTH = N_HEADS * V_DIM
ROPE_THETA = 10000.0
Q_BLOCK = 128
NORM_EPS = 1e-6
IN_SPLITS = (POOL_WIDTH, POOL_WIDTH, Q_LORA, KV_LORA + QK_ROPE, MLA_WIDTH, D_MODEL, D_MODEL)
IN_WIDTH = sum(IN_SPLITS)

kernel_name = "hybrid_pool_mla_prefix_dit_block"


def rms_norm(x, g):
    xf = x.astype(jnp.float32)
    y = xf * lax.rsqrt(jnp.mean(xf * xf, axis=-1, keepdims=True) + NORM_EPS)
    return y.astype(x.dtype) * g


def ada_params(cond, w, b):
    m = jax.nn.silu(cond) @ w + b
    return jnp.split(m, 3, axis=-1)


def split_in(p):
    offsets = [int(o) for o in np.cumsum(IN_SPLITS)[:-1]]
    return jnp.split(p, offsets, axis=-1)


def axial_rope_tables(n_tokens):
    rows = n_tokens // GRID_W
    t_row = jnp.repeat(jnp.arange(rows, dtype=jnp.float32), GRID_W)
    t_col = jnp.tile(jnp.arange(GRID_W, dtype=jnp.float32), rows)
    half = QK_ROPE // 2
    inv = 1.0 / (ROPE_THETA ** (jnp.arange(0, half, 2, dtype=jnp.float32) / half))
    ang_r = t_row[:, None] * inv
    ang_c = t_col[:, None] * inv
    ang = jnp.concatenate([ang_r, ang_r, ang_c, ang_c], axis=-1)
    return jnp.cos(ang), jnp.sin(ang)


def apply_rope(x, cos, sin):
    xr1, xr2, xc1, xc2 = jnp.split(x, 4, axis=-1)
    rot = jnp.concatenate([-xr2, xr1, -xc2, xc1], axis=-1)
    return (x * cos + rot * sin).astype(x.dtype)


def pool_mix(u, w_pool, pool_scale):
    B, L, _ = u.shape
    ug = u.reshape(B, L, POOL_GROUPS, POOL_GROUP_DIM)
    cs = jnp.cumsum(ug.astype(jnp.float32), axis=1)
    cs = jnp.concatenate([jnp.zeros_like(cs[:, :1]), cs], axis=1)
    t = jnp.arange(L)
    pooled = []
    for gi, w in enumerate(POOL_WINDOWS):
        lo = jnp.clip(t - w // 2, 0, L)
        hi = jnp.clip(t + w // 2, 0, L)
        cnt = (hi - lo).astype(jnp.float32)
        csg = cs[:, :, gi]
        pooled.append((csg[:, hi] - csg[:, lo]) / cnt[:, None])
    pooled = jnp.stack(pooled, axis=2).astype(u.dtype)
    d = pooled - ug
    out = jnp.einsum('blgc,gcd->blgd', d, w_pool).reshape(B, L, POOL_WIDTH)
    return out * pool_scale


def mla_project(q_a, kv_a, q_norm_g, w_qb, kv_norm_g, w_kvb, rope):
    B, L, _ = q_a.shape
    q = (rms_norm(q_a, q_norm_g) @ w_qb).reshape(B, L, N_HEADS, QK_NOPE + QK_ROPE)
    q_nope, q_rope = q[..., :QK_NOPE], q[..., QK_NOPE:]
    c_kv, k_rope = kv_a[..., :KV_LORA], kv_a[..., KV_LORA:]
    kv = (rms_norm(c_kv, kv_norm_g) @ w_kvb).reshape(B, L, N_HEADS, QK_NOPE + V_DIM)
    k_nope, v = kv[..., :QK_NOPE], kv[..., QK_NOPE:]
    if rope is not None:
        cos, sin = rope
        q_rope = apply_rope(q_rope, cos[:, None, :], sin[:, None, :])
        k_rope = apply_rope(k_rope, cos, sin)
    return q_nope, q_rope, k_nope, k_rope, v


def block_attention(q_nope, q_rope, k_nope, k_rope, v):
    B, L, H, _ = q_nope.shape
    nb = L // Q_BLOCK
    scale = (QK_NOPE + QK_ROPE) ** -0.5

    def to_blocks(q):
        return q.reshape(B, nb, Q_BLOCK, H, q.shape[-1]).transpose(1, 0, 2, 3, 4)

    def one_block(qs):
        qn, qr = qs
        s = jnp.einsum('bqhd,bkhd->bhqk', qn, k_nope) + jnp.einsum('bqhr,bkr->bhqk', qr, k_rope)
        p = jax.nn.softmax(s.astype(jnp.float32) * scale, axis=-1).astype(v.dtype)
        return jnp.einsum('bhqk,bkhd->bqhd', p, v)

    o = lax.map(one_block, (to_blocks(q_nope), to_blocks(q_rope)))
    return o.transpose(1, 0, 2, 3, 4).reshape(B, L, H * V_DIM)


def merge_branches(pool_out, pool_gate, attn_out, mla_gate, m_pool, m_mla, b_gate, w_proj_pool, w_proj_mla, w_out):
    y_pool = (pool_out * jax.nn.silu(pool_gate)) @ w_proj_pool
    y_mla = (attn_out * jax.nn.silu(mla_gate)) @ w_proj_mla
    g_pool = jax.nn.sigmoid(m_pool + b_gate[:D_MODEL])
    g_mla = jax.nn.sigmoid(m_mla + b_gate[D_MODEL:])
    return (g_pool * y_pool + g_mla * y_mla) @ w_out


def setup_inputs(seed: int = 0) -> dict:
    key = jax.random.key(seed)
    ks = jax.random.split(key, 20)
    f32 = jnp.float32
    n = lambda k, shape, s: jax.random.normal(k, shape, f32) * s
    return {
        "x": n(ks[0], (BATCH, SEQ, D_MODEL), 1.0),
        "c": n(ks[1], (BATCH, D_MODEL), 1.0),
        "ctx": n(ks[2], (BATCH, CTX_LEN, D_MODEL), 1.0),
        "c_ctx": n(ks[3], (D_MODEL,), 1.0),
        "ada_w": n(ks[4], (DEPTH, D_MODEL, 3 * D_MODEL), D_MODEL ** -0.5),
        "ada_b": n(ks[5], (DEPTH, 3 * D_MODEL), 0.02),
        "norm_g": 1.0 + n(ks[6], (DEPTH, D_MODEL), 0.05),
        "w_in": n(ks[7], (DEPTH, D_MODEL, IN_WIDTH), D_MODEL ** -0.5),
        "b_gate": n(ks[8], (DEPTH, 2 * D_MODEL), 0.02),
        "w_pool": n(ks[9], (DEPTH, POOL_GROUPS, POOL_GROUP_DIM, POOL_GROUP_DIM), POOL_GROUP_DIM ** -0.5),
        "pool_scale": 1.0 + n(ks[10], (DEPTH, POOL_WIDTH), 0.1),
        "q_norm_g": 1.0 + n(ks[11], (DEPTH, Q_LORA), 0.05),
        "w_qb": n(ks[12], (DEPTH, Q_LORA, N_HEADS * (QK_NOPE + QK_ROPE)), Q_LORA ** -0.5),
        "kv_norm_g": 1.0 + n(ks[13], (DEPTH, KV_LORA), 0.05),
        "w_kvb": n(ks[14], (DEPTH, KV_LORA, N_HEADS * (QK_NOPE + V_DIM)), KV_LORA ** -0.5),
        "w_proj_pool": n(ks[15], (DEPTH, POOL_WIDTH, D_MODEL), POOL_WIDTH ** -0.5),
        "w_proj_mla": n(ks[16], (DEPTH, MLA_WIDTH, D_MODEL), MLA_WIDTH ** -0.5),
        "w_out": n(ks[17], (DEPTH, D_MODEL, D_MODEL), D_MODEL ** -0.5),
        "final_g": 1.0 + n(ks[18], (D_MODEL,), 0.05),
    }


def reference(x, c, ctx, c_ctx, ada_w, ada_b, norm_g, w_in, b_gate, w_pool, pool_scale, q_norm_g, w_qb,
              kv_norm_g, w_kvb, w_proj_pool, w_proj_mla, w_out, final_g):
    rope = axial_rope_tables(x.shape[1])
    for l in range(DEPTH):
        last = l == DEPTH - 1
        shift, scale, gate = ada_params(c, ada_w[l], ada_b[l])
        shift_c, scale_c, gate_c = ada_params(c_ctx, ada_w[l], ada_b[l])
        hx = rms_norm(x, norm_g[l]) * (1.0 + scale[:, None]) + shift[:, None]
        hc = rms_norm(ctx, norm_g[l]) * (1.0 + scale_c) + shift_c
        ux, gpx, qax, kvax, gmx, mpx, mmx = split_in(hx @ w_in[l])
        uc, gpc, qac, kvac, gmc, mpc, mmc = split_in(hc @ w_in[l])
        qn_x, qr_x, kn_x, kr_x, v_x = mla_project(qax, kvax, q_norm_g[l], w_qb[l], kv_norm_g[l], w_kvb[l], rope)
        qn_c, qr_c, kn_c, kr_c, v_c = mla_project(qac, kvac, q_norm_g[l], w_qb[l], kv_norm_g[l], w_kvb[l], None)
        attn_x = block_attention(qn_x, qr_x,
                                 jnp.concatenate([kn_x, kn_c], axis=1),
                                 jnp.concatenate([kr_x, kr_c], axis=1),
                                 jnp.concatenate([v_x, v_c], axis=1))
        pool_x = pool_mix(ux, w_pool[l], pool_scale[l])
        if not last:
            attn_c = block_attention(qn_c, qr_c, kn_c, kr_c, v_c)
            pool_c = pool_mix(uc, w_pool[l], pool_scale[l])
            ctx = ctx + gate_c * merge_branches(pool_c, gpc, attn_c, gmc, mpc, mmc, b_gate[l],
                                                w_proj_pool[l], w_proj_mla[l], w_out[l])
        x = x + gate[:, None] * merge_branches(pool_x, gpx, attn_x, gmx, mpx, mmx, b_gate[l],
                                               w_proj_pool[l], w_proj_mla[l], w_out[l])
    return rms_norm(x, final_g)
```

```cpp
#include <hip/hip_runtime.h>
#include <cstdint>
#include <cstdio>

typedef unsigned short bf16_t;

constexpr int D = 1024, NB = 16, S = 2048, CTX = 256, M = NB * S, MC = NB * CTX, MT = M + MC, NKEY = S + CTX;
constexpr int NH = 16, QKN = 128, QKR = 64, VD = 128, QL = 256, KVL = 128, QKD = QKN + QKR;
constexpr int INW = 6592, N1 = 6656;
constexpr int C_U = 0, C_GP = 1024, C_QA = 2048, C_GM = 2304, C_MP = 4352, C_MM = 5376, C_KV = 6400;
constexpr float EPS = 1e-6f;

constexpr size_t al256(size_t x) { return (x + 255) / 256 * 256; }
constexpr size_t WS_ADA   = 0;
constexpr size_t WS_ROPE  = WS_ADA   + al256((size_t)17 * 3072 * 4);
constexpr size_t WS_WINT  = WS_ROPE  + al256((size_t)64 * 16 * 2 * 4);
constexpr size_t WS_WPOOL = WS_WINT  + al256((size_t)N1 * D * 2);
constexpr size_t WS_WPP   = WS_WPOOL + al256((size_t)1024 * 256 * 2);
constexpr size_t WS_WPM   = WS_WPP   + al256((size_t)1024 * 1024 * 2);
constexpr size_t WS_WOUT  = WS_WPM   + al256((size_t)1024 * 2048 * 2);
constexpr size_t WS_WQT   = WS_WOUT  + al256((size_t)1024 * 1024 * 2);
constexpr size_t WS_WVBT  = WS_WQT   + al256((size_t)NH * QKD * QL * 2);
constexpr size_t WS_U     = WS_WVBT  + al256((size_t)NH * VD * KVL * 2);
constexpr size_t WS_SGP   = WS_U     + al256((size_t)M * 1024 * 2);
constexpr size_t WS_SGM   = WS_SGP   + al256((size_t)M * 1024 * 2);
constexpr size_t WS_QA    = WS_SGM   + al256((size_t)M * 2048 * 2);
constexpr size_t WS_GMP   = WS_QA    + al256((size_t)M * 256 * 2);
constexpr size_t WS_GMM   = WS_GMP   + al256((size_t)M * 1024 * 2);
constexpr size_t WS_KVA   = WS_GMM   + al256((size_t)M * 1024 * 2);
constexpr size_t WS_KC    = WS_KVA   + al256((size_t)MT * 256 * 4);
constexpr size_t WS_END   = WS_KC    + al256((size_t)NB * NKEY * QKD * 2);

__device__ __forceinline__ bf16_t f2bf(float f) { unsigned u = __float_as_uint(f); u += 0x7fffu + ((u >> 16) & 1u); return (bf16_t)(u >> 16); }
__device__ __forceinline__ float bf2f(bf16_t b) { return __uint_as_float(((unsigned)b) << 16); }
__device__ __forceinline__ float siluf(float v) { return v / (1.f + __expf(-v)); }
__device__ __forceinline__ float sigmf(float v) { return 1.f / (1.f + __expf(-v)); }

__device__ __forceinline__ float block_sum_256(float v, float* red  ) {
    for (int o = 32; o > 0; o >>= 1) v += __shfl_xor(v, o);
    __syncthreads();
    if ((threadIdx.x & 63) == 0) red[threadIdx.x >> 6] = v;
    __syncthreads();
    return red[0] + red[1] + red[2] + red[3];
}

__global__ __launch_bounds__(256) void k_ada(const float* __restrict__ c, const float* __restrict__ c_ctx, const float* __restrict__ ada_w,
                                             const float* __restrict__ ada_b, float* __restrict__ ada) {
    const int j = blockIdx.x * 256 + threadIdx.x, r = blockIdx.y;
    const float* cond = r < 16 ? c + r * D : c_ctx;
    float acc = 0.f;
    for (int k = 0; k < D; ++k) acc += siluf(cond[k]) * ada_w[(size_t)k * 3072 + j];
    ada[r * 3072 + j] = acc + ada_b[j];
}

__global__ __launch_bounds__(256) void k_transpose(const float* __restrict__ src, int ld, int K, int N, bf16_t* __restrict__ dst, int mode, const float* __restrict__ kscale) {
    __shared__ float tile[64 * 65];
    const int tilesN = N / 64, tn = blockIdx.x % tilesN, tk = blockIdx.x / tilesN;
    for (int i = threadIdx.x; i < 4096; i += 256) {
        const int kk = i >> 6, nn = i & 63, n = tn * 64 + nn; int col;
        if (mode == 0) col = n;
        else if (mode == 1) col = n < C_GM ? n : (n < C_KV ? n + 192 : (n < C_KV + 192 ? n - C_KV + 2304 : -1));
        else if (mode == 2) col = (n >> 7) * 256 + 128 + (n & 127);
        else col = (n / 64) * 192 + 128 + (n % 64);
        const int k = tk * 64 + kk;
        tile[kk * 65 + nn] = col >= 0 ? src[(size_t)k * ld + col] * (kscale ? kscale[k] : 1.f) : 0.f;
    }
    __syncthreads();
    for (int i = threadIdx.x; i < 4096; i += 256) {
        const int nn = i >> 6, kk = i & 63, n = tn * 64 + nn; size_t drow;
        if (mode == 3) drow = (size_t)(n / 64) * 192 + 128 + (n % 64); else drow = n;
        dst[drow * K + tk * 64 + kk] = f2bf(tile[kk * 65 + nn]);
    }
}
__global__ __launch_bounds__(256) void k_wcomb(const float* __restrict__ w_qb, const float* __restrict__ w_kvb, const float* __restrict__ qg, bf16_t* __restrict__ WqT) {
    const int k = threadIdx.x, l = blockIdx.x, h = blockIdx.y;
    const float* a = w_qb + (size_t)k * 3072 + h * 192; const float* b = w_kvb + (size_t)l * 4096 + h * 256;
    float acc = 0.f;
    for (int j = 0; j < 128; ++j) acc += a[j] * b[j];
    WqT[((size_t)h * 192 + l) * 256 + k] = f2bf(acc * qg[k]);
}
__global__ void k_rope_table(float* __restrict__ rope) {
    const int pos = blockIdx.x, i = threadIdx.x;
    const float inv = powf(10000.f, -(float)i / 16.f), a = (float)pos * inv;
    rope[(pos * 16 + i) * 2 + 0] = cosf(a); rope[(pos * 16 + i) * 2 + 1] = sinf(a);
}

__global__ __launch_bounds__(256) void k_h(const float* __restrict__ x, const float* __restrict__ ctx, const float* __restrict__ norm_g, const float* __restrict__ ada, bf16_t* __restrict__ H) {
    __shared__ float red[4];
    const int row = blockIdx.x; const bool isx = row < M;
    const float* src = isx ? x + (size_t)row * D : ctx + (size_t)(row - M) * D;
    const int ar = isx ? row / S : 16;
    const float4 v = *(const float4*)(src + threadIdx.x * 4);
    const float ss = block_sum_256(v.x * v.x + v.y * v.y + v.z * v.z + v.w * v.w, red);
    const float rinv = rsqrtf(ss * (1.f / D) + EPS);
    const float* sh = ada + ar * 3072, *sc = sh + 1024;
    const int c0 = threadIdx.x * 4; const float vv[4] = {v.x, v.y, v.z, v.w};
    for (int i = 0; i < 4; ++i) H[(size_t)row * D + c0 + i] = f2bf(vv[i] * rinv * norm_g[c0 + i] * (1.f + sc[c0 + i]) + sh[c0 + i]);
}

struct GemmP { const bf16_t* A; int lda; int a_koff_pn; const bf16_t* Bt; int ldb; int M, N, K; int row_off, col_off; };

struct Epi1 {
    bf16_t *U, *SGP, *QA, *SGM, *GMP, *GMM; float* KVA; const float* b_gate;
    __device__ __forceinline__ void operator()(int row, int col, const float* v) const {
        if (col < C_GP) { for (int j = 0; j < 4; ++j) U[(size_t)row * 1024 + col + j] = f2bf(v[j]); }
        else if (col < C_QA) { for (int j = 0; j < 4; ++j) SGP[(size_t)row * 1024 + col - C_GP + j] = f2bf(siluf(v[j])); }
        else if (col < C_GM) { for (int j = 0; j < 4; ++j) QA[(size_t)row * 256 + col - C_QA + j] = f2bf(v[j]); }
        else if (col < C_MP) { for (int j = 0; j < 4; ++j) SGM[(size_t)row * 2048 + col - C_GM + j] = f2bf(siluf(v[j])); }
        else if (col < C_MM) { for (int j = 0; j < 4; ++j) GMP[(size_t)row * 1024 + col - C_MP + j] = f2bf(sigmf(v[j] + b_gate[col - C_MP + j])); }
        else if (col < C_KV) { for (int j = 0; j < 4; ++j) GMM[(size_t)row * 1024 + col - C_MM + j] = f2bf(sigmf(v[j] + b_gate[1024 + col - C_MM + j])); }
        else { for (int j = 0; j < 4; ++j) KVA[(size_t)row * 256 + col - C_KV + j] = v[j]; }
    }
};
struct Epi2 {
    const float* pool_scale; const bf16_t* SGP; bf16_t* P1;
    __device__ __forceinline__ void operator()(int row, int col, const float* v) const {
        for (int j = 0; j < 4; ++j) P1[(size_t)row * 1024 + col + j] = f2bf(v[j] * pool_scale[col + j] * bf2f(SGP[(size_t)row * 1024 + col + j]));
    }
};
struct Epi3a {
    const bf16_t* GMP; float* T;
    __device__ __forceinline__ void operator()(int row, int col, const float* v) const {
        for (int j = 0; j < 4; ++j) T[(size_t)row * 1024 + col + j] = v[j] * bf2f(GMP[(size_t)row * 1024 + col + j]);
    }
};
struct Epi3b {
    const bf16_t* GMM; const float* T; bf16_t* Z;
    __device__ __forceinline__ void operator()(int row, int col, const float* v) const {
        for (int j = 0; j < 4; ++j) Z[(size_t)row * 1024 + col + j] = f2bf(T[(size_t)row * 1024 + col + j] + v[j] * bf2f(GMM[(size_t)row * 1024 + col + j]));
    }
};
struct Epi4 {
    const float* x; const float* ada; float* XN;
    __device__ __forceinline__ void operator()(int row, int col, const float* v) const {
        const float* gate = ada + (row / S) * 3072 + 2048;
        for (int j = 0; j < 4; ++j) XN[(size_t)row * 1024 + col + j] = x[(size_t)row * 1024 + col + j] + gate[col + j] * v[j];
    }
};

template <class Epi>
__global__ __launch_bounds__(256) void k_gemm(GemmP g, Epi epi) {
    __shared__ __attribute__((aligned(16))) float As[32][68];
    __shared__ __attribute__((aligned(16))) float Bs[32][68];
    const int tid = threadIdx.x, tx = tid & 15, ty = tid >> 4;
    const int row0 = blockIdx.y * 64, col0 = blockIdx.x * 64;
    const bf16_t* Ab = g.A + (size_t)row0 * g.lda + (size_t)((col0 + g.col_off) / 256) * g.a_koff_pn;
    const bf16_t* Bb = g.Bt + (size_t)col0 * g.ldb;
    float acc[4][4] = {};
    const int lr = tid >> 2, lk = (tid & 3) * 8;
    for (int k0 = 0; k0 < g.K; k0 += 32) {
        const uint4 va = *(const uint4*)(Ab + (size_t)lr * g.lda + k0 + lk);
        const uint4 vb = *(const uint4*)(Bb + (size_t)lr * g.ldb + k0 + lk);
        const unsigned wa[4] = {va.x, va.y, va.z, va.w}, wb[4] = {vb.x, vb.y, vb.z, vb.w};
        for (int i = 0; i < 4; ++i) {
            As[lk + 2 * i][lr] = __uint_as_float(wa[i] << 16); As[lk + 2 * i + 1][lr] = __uint_as_float(wa[i] & 0xffff0000u);
            Bs[lk + 2 * i][lr] = __uint_as_float(wb[i] << 16); Bs[lk + 2 * i + 1][lr] = __uint_as_float(wb[i] & 0xffff0000u);
        }
        __syncthreads();
#pragma unroll
        for (int k = 0; k < 32; ++k) {
            const float4 a = *(const float4*)&As[k][ty * 4]; const float4 b = *(const float4*)&Bs[k][tx * 4];
            const float av[4] = {a.x, a.y, a.z, a.w}, bv[4] = {b.x, b.y, b.z, b.w};
#pragma unroll
            for (int i = 0; i < 4; ++i)
#pragma unroll
                for (int j = 0; j < 4; ++j) acc[i][j] += av[i] * bv[j];
        }
        __syncthreads();
    }
    for (int i = 0; i < 4; ++i) epi(row0 + ty * 4 + i + g.row_off, col0 + tx * 4 + g.col_off, acc[i]);
}

__global__ __launch_bounds__(64) void k_kprep(const float* __restrict__ KVA, const float* __restrict__ kvg, const float* __restrict__ rope, bf16_t* __restrict__ KC) {
    const int t = blockIdx.x, lane = threadIdx.x; const bool isx = t < M;
    const int b = isx ? t / S : (t - M) / CTX, pos = isx ? t % S : (t - M) % CTX, key = isx ? pos : S + pos;
    const float* src = KVA + (size_t)t * 256;
    const float c0 = src[lane], c1 = src[64 + lane];
    float ss = c0 * c0 + c1 * c1; for (int o = 32; o > 0; o >>= 1) ss += __shfl_xor(ss, o);
    const float rinv = rsqrtf(ss * (1.f / KVL) + EPS);
    bf16_t* dst = KC + ((size_t)b * NKEY + key) * QKD;
    dst[lane] = f2bf(c0 * rinv * kvg[lane]); dst[64 + lane] = f2bf(c1 * rinv * kvg[64 + lane]);
    float kr = src[128 + lane];
    if (isx) {
        const int half = lane >> 5, w = lane & 31, i = w & 15, p = half ? (pos & 63) : (pos >> 6);
        const float other = __shfl_xor(kr, 16);
        const float cs = rope[(p * 16 + i) * 2], sn = rope[(p * 16 + i) * 2 + 1];
        kr = (w < 16) ? kr * cs - other * sn : kr * cs + other * sn;
    }
    dst[128 + lane] = f2bf(kr);
}
__global__ __launch_bounds__(256) void k_pooldiff(const bf16_t* __restrict__ U, bf16_t* __restrict__ Dp) {
    const int t = blockIdx.x, pos = t % S;
    for (int i = 0; i < 4; ++i) {
        const int col = threadIdx.x + i * 256, g = col >> 8, hw = 1 << g;
        const int lo = max(pos - hw, 0), hi = min(pos + hw, S);
        float s = 0.f; for (int p = lo; p < hi; ++p) s += bf2f(U[(size_t)(t - pos + p) * 1024 + col]);
        const float pooled = s / (float)(hi - lo);
        Dp[(size_t)t * 1024 + col] = f2bf(pooled - bf2f(U[(size_t)t * 1024 + col]));
    }
}

__global__ __launch_bounds__(256) void k_attn(const bf16_t* __restrict__ QA, const bf16_t* __restrict__ WqT, const bf16_t* __restrict__ KC, const bf16_t* __restrict__ WvbT,
                                              const float* __restrict__ rope, bf16_t* __restrict__ SGM_A2) {
    __shared__ float qs[4][QKD]; __shared__ float ps[4][NKEY]; __shared__ float ol[4][KVL]; __shared__ float qa[4][QL];
    const int w = threadIdx.x >> 6, lane = threadIdx.x & 63;
    const int gq = blockIdx.x * 4 + w;
    const int s = gq % S, h = (gq / S) % NH, b = gq / (S * NH), t = b * S + s;
    float ss = 0.f;
    for (int i = 0; i < 4; ++i) { const float v = bf2f(QA[(size_t)t * QL + lane + 64 * i]); qa[w][lane + 64 * i] = v; ss += v * v; }
    for (int o = 32; o > 0; o >>= 1) ss += __shfl_xor(ss, o);
    const float rinv = rsqrtf(ss * (1.f / QL) + EPS);
    __syncthreads();
    for (int i = 0; i < 3; ++i) { const int r = lane + 64 * i; const bf16_t* wr = WqT + ((size_t)h * QKD + r) * QL;
        float acc = 0.f; for (int k = 0; k < QL; ++k) acc += qa[w][k] * bf2f(wr[k]);
        qs[w][r] = acc * rinv; }
    __syncthreads();
    if (lane < 32) { const int half = lane >> 4, i = lane & 15, p = half ? (s & 63) : (s >> 6);
        const float a = qs[w][128 + half * 32 + i], bb = qs[w][128 + half * 32 + 16 + i];
        const float cs = rope[(p * 16 + i) * 2], sn = rope[(p * 16 + i) * 2 + 1];
        qs[w][128 + half * 32 + i] = a * cs - bb * sn; qs[w][128 + half * 32 + 16 + i] = bb * cs + a * sn; }
    __syncthreads();
    for (int i = 0; i < 3; ++i) { const int r = lane + 64 * i; qs[w][r] = bf2f(f2bf(qs[w][r])); }
    __syncthreads();
    const float scale = 0.07216878364870322f;
    const bf16_t* Kb = KC + (size_t)b * NKEY * QKD;
    float mx = -1e30f;
    for (int key = lane; key < NKEY; key += 64) {
        const uint4* kr = (const uint4*)(Kb + (size_t)key * QKD); float acc = 0.f;
        for (int c = 0; c < QKD / 8; ++c) { const uint4 v = kr[c]; const unsigned wv[4] = {v.x, v.y, v.z, v.w};
            for (int j = 0; j < 4; ++j) acc += qs[w][c * 8 + 2 * j] * __uint_as_float(wv[j] << 16) + qs[w][c * 8 + 2 * j + 1] * __uint_as_float(wv[j] & 0xffff0000u); }
        acc *= scale; ps[w][key] = acc; mx = fmaxf(mx, acc);
    }
    for (int o = 32; o > 0; o >>= 1) mx = fmaxf(mx, __shfl_xor(mx, o));
    float l = 0.f;
    for (int key = lane; key < NKEY; key += 64) { const float p = __expf(ps[w][key] - mx); l += p; ps[w][key] = bf2f(f2bf(p)); }
    for (int o = 32; o > 0; o >>= 1) l += __shfl_xor(l, o);
    __syncthreads();
    float o0 = 0.f, o1 = 0.f;
    for (int key = 0; key < NKEY; ++key) { const unsigned v = *(const unsigned*)(Kb + (size_t)key * QKD + 2 * lane); const float p = ps[w][key];
        o0 += p * __uint_as_float(v << 16); o1 += p * __uint_as_float(v & 0xffff0000u); }
    ol[w][2 * lane] = bf2f(f2bf(o0 / l)); ol[w][2 * lane + 1] = bf2f(f2bf(o1 / l));
    __syncthreads();
    for (int i = 0; i < 2; ++i) { const int v = lane + 64 * i; const bf16_t* wr = WvbT + ((size_t)h * VD + v) * KVL;
        float acc = 0.f; for (int k = 0; k < KVL; ++k) acc += ol[w][k] * bf2f(wr[k]);
        bf16_t* dst = SGM_A2 + (size_t)t * 2048 + h * VD + v; *dst = f2bf(acc * bf2f(*dst)); }
}

__global__ __launch_bounds__(256) void k_final(float* __restrict__ out, const float* __restrict__ final_g) {
    __shared__ float red[4];
    float* p = out + (size_t)blockIdx.x * D + threadIdx.x * 4; const float4 v = *(const float4*)p;
    const float ss = block_sum_256(v.x * v.x + v.y * v.y + v.z * v.z + v.w * v.w, red);
    const float rinv = rsqrtf(ss * (1.f / D) + EPS); const float4 g = *(const float4*)(final_g + threadIdx.x * 4);
    *(float4*)p = make_float4(v.x * rinv * g.x, v.y * rinv * g.y, v.z * rinv * g.z, v.w * rinv * g.w);
}

extern "C" void kernel_launch(void* const* d_in, const int* in_sizes, int n_in, void* d_out, int out_size, void* d_ws, size_t ws_size, hipStream_t stream) {
    if (ws_size < WS_END) { fprintf(stderr, "kernel_launch: workspace too small: %zu < %zu\n", ws_size, WS_END); return; }
    const float* x = (const float*)d_in[0]; const float* c = (const float*)d_in[1]; const float* ctx = (const float*)d_in[2]; const float* c_ctx = (const float*)d_in[3];
    const float* ada_w = (const float*)d_in[4]; const float* ada_b = (const float*)d_in[5]; const float* norm_g = (const float*)d_in[6]; const float* w_in = (const float*)d_in[7];
    const float* b_gate = (const float*)d_in[8]; const float* w_pool = (const float*)d_in[9]; const float* pool_scale = (const float*)d_in[10]; const float* q_norm_g = (const float*)d_in[11];
    const float* w_qb = (const float*)d_in[12]; const float* kv_norm_g = (const float*)d_in[13]; const float* w_kvb = (const float*)d_in[14]; const float* w_pp = (const float*)d_in[15];
    const float* w_pm = (const float*)d_in[16]; const float* w_out = (const float*)d_in[17]; const float* final_g = (const float*)d_in[18];
    char* ws = (char*)d_ws; float* out = (float*)d_out;
    float* ADA = (float*)(ws + WS_ADA); float* ROPE = (float*)(ws + WS_ROPE);
    bf16_t* WINT = (bf16_t*)(ws + WS_WINT); bf16_t* WPOOL = (bf16_t*)(ws + WS_WPOOL); bf16_t* WPP = (bf16_t*)(ws + WS_WPP); bf16_t* WPM = (bf16_t*)(ws + WS_WPM);
    bf16_t* WOUT = (bf16_t*)(ws + WS_WOUT); bf16_t* WQT = (bf16_t*)(ws + WS_WQT); bf16_t* WVBT = (bf16_t*)(ws + WS_WVBT);
    bf16_t* U = (bf16_t*)(ws + WS_U); bf16_t* SGP = (bf16_t*)(ws + WS_SGP); bf16_t* SGM = (bf16_t*)(ws + WS_SGM); bf16_t* QA = (bf16_t*)(ws + WS_QA);
    bf16_t* GMP = (bf16_t*)(ws + WS_GMP); bf16_t* GMM = (bf16_t*)(ws + WS_GMM); float* KVA = (float*)(ws + WS_KVA); bf16_t* KC = (bf16_t*)(ws + WS_KC);
    bf16_t* H = (bf16_t*)d_out; bf16_t* Dp = (bf16_t*)d_out; float* T = (float*)d_out; bf16_t* P1 = U; bf16_t* Z = SGP;

    k_ada<<<dim3(12, 17), 256, 0, stream>>>(c, c_ctx, ada_w, ada_b, ADA);
    k_rope_table<<<64, 16, 0, stream>>>(ROPE);
    k_transpose<<<(N1 / 64) * (1024 / 64), 256, 0, stream>>>(w_in, INW, 1024, N1, WINT, 1, nullptr);
    for (int g = 0; g < 4; ++g) k_transpose<<<4 * 4, 256, 0, stream>>>(w_pool + (size_t)g * 65536, 256, 256, 256, WPOOL + (size_t)g * 65536, 0, nullptr);
    k_transpose<<<16 * 16, 256, 0, stream>>>(w_pp, 1024, 1024, 1024, WPP, 0, nullptr);
    k_transpose<<<16 * 32, 256, 0, stream>>>(w_pm, 1024, 2048, 1024, WPM, 0, nullptr);
    k_transpose<<<16 * 16, 256, 0, stream>>>(w_out, 1024, 1024, 1024, WOUT, 0, nullptr);
    k_transpose<<<32 * 2, 256, 0, stream>>>(w_kvb, 4096, 128, 2048, WVBT, 2, nullptr);
    k_transpose<<<16 * 4, 256, 0, stream>>>(w_qb, 3072, 256, 1024, WQT, 3, q_norm_g);
    k_wcomb<<<dim3(128, 16), 256, 0, stream>>>(w_qb, w_kvb, q_norm_g, WQT);
    k_h<<<MT, 256, 0, stream>>>(x, ctx, norm_g, ADA, H);
    Epi1 e1{U, SGP, QA, SGM, GMP, GMM, KVA, b_gate};
    k_gemm<Epi1><<<dim3(N1 / 64, M / 64), 256, 0, stream>>>(GemmP{H, 1024, 0, WINT, 1024, M, N1, 1024, 0, 0}, e1);
    k_gemm<Epi1><<<dim3(256 / 64, MC / 64), 256, 0, stream>>>(GemmP{H + (size_t)M * 1024, 1024, 0, WINT + (size_t)C_KV * 1024, 1024, MC, 256, 1024, M, C_KV}, e1);
    k_kprep<<<MT, 64, 0, stream>>>(KVA, kv_norm_g, ROPE, KC);
    k_pooldiff<<<M, 256, 0, stream>>>(U, Dp);
    k_gemm<Epi2><<<dim3(1024 / 64, M / 64), 256, 0, stream>>>(GemmP{Dp, 1024, 256, WPOOL, 256, M, 1024, 256, 0, 0}, Epi2{pool_scale, SGP, P1});
    k_attn<<<NB * NH * S / 4, 256, 0, stream>>>(QA, WQT, KC, WVBT, ROPE, SGM);
    k_gemm<Epi3a><<<dim3(1024 / 64, M / 64), 256, 0, stream>>>(GemmP{P1, 1024, 0, WPP, 1024, M, 1024, 1024, 0, 0}, Epi3a{GMP, T});
    k_gemm<Epi3b><<<dim3(1024 / 64, M / 64), 256, 0, stream>>>(GemmP{SGM, 2048, 0, WPM, 2048, M, 1024, 2048, 0, 0}, Epi3b{GMM, T, Z});
    k_gemm<Epi4><<<dim3(1024 / 64, M / 64), 256, 0, stream>>>(GemmP{Z, 1024, 0, WOUT, 1024, M, 1024, 1024, 0, 0}, Epi4{x, ADA, out});
    k_final<<<M, 256, 0, stream>>>(out, final_g);
}
```

```cpp
#include <hip/hip_runtime.h>
#include <hip/hip_cooperative_groups.h>
#include <cstdint>
#include <cstdio>
namespace cg = cooperative_groups;

typedef unsigned short bf16_t;
typedef short bf16x8 __attribute__((ext_vector_type(8)));
typedef float f32x4 __attribute__((ext_vector_type(4)));
typedef unsigned u32x4 __attribute__((ext_vector_type(4)));
typedef unsigned u32x2 __attribute__((ext_vector_type(2)));
#define LAS __attribute__((address_space(3)))

constexpr int D = 1024, NB = 16, S = 2048, CTX = 256, M = NB * S, MC = NB * CTX, MT = M + MC, NKEY = S + CTX;
constexpr int NH = 16, QKN = 128, QKR = 64, VD = 128, QL = 256, KVL = 128, QKD = QKN + QKR;
constexpr int INW = 6592, N1 = 6656;
constexpr int C_U = 0, C_GP = 1024, C_QA = 2048, C_GM = 2304, C_MP = 4352, C_MM = 5376, C_KV = 6400;
constexpr float EPS = 1e-6f;
constexpr int NTHREADS = 512, NWAVES = 8;
constexpr int LDS_BYTES = 147456;

constexpr size_t al256(size_t x) { return (x + 255) / 256 * 256; }
constexpr size_t WS_ADA   = 0;
constexpr size_t WS_ROPE  = WS_ADA   + al256((size_t)17 * 3072 * 4);
constexpr size_t WS_WINT  = WS_ROPE  + al256((size_t)64 * 16 * 2 * 4);
constexpr size_t WS_WPOOL = WS_WINT  + al256((size_t)N1 * D * 2);
constexpr size_t WS_WPP   = WS_WPOOL + al256((size_t)1024 * 256 * 2);
constexpr size_t WS_WPM   = WS_WPP   + al256((size_t)1024 * 1024 * 2);
constexpr size_t WS_WOUT  = WS_WPM   + al256((size_t)1024 * 2048 * 2);
constexpr size_t WS_WQT   = WS_WOUT  + al256((size_t)1024 * 1024 * 2);
constexpr size_t WS_WVBT  = WS_WQT   + al256((size_t)NH * QKD * QL * 2);
constexpr size_t WS_U     = WS_WVBT  + al256((size_t)NH * VD * KVL * 2);
constexpr size_t WS_SGP   = WS_U     + al256((size_t)M * 1024 * 2);
constexpr size_t WS_SGM   = WS_SGP   + al256((size_t)M * 1024 * 2);
constexpr size_t WS_QA    = WS_SGM   + al256((size_t)M * 2048 * 2);
constexpr size_t WS_GMP   = WS_QA    + al256((size_t)M * 256 * 2);
constexpr size_t WS_GMM   = WS_GMP   + al256((size_t)M * 1024 * 2);
constexpr size_t WS_KVA   = WS_GMM   + al256((size_t)M * 1024 * 2);
constexpr size_t WS_KC    = WS_KVA   + al256((size_t)MT * 256 * 4);
constexpr size_t WS_BAR   = WS_KC    + al256((size_t)NB * NKEY * QKD * 2);
constexpr size_t BAR_BYTES = 16384;
constexpr size_t WS_END   = WS_BAR   + BAR_BYTES;

struct Params {
    const float *x, *c, *ctx, *c_ctx, *ada_w, *ada_b, *norm_g, *w_in, *b_gate, *w_pool, *pool_scale, *q_norm_g, *w_qb, *kv_norm_g, *w_kvb, *w_pp, *w_pm, *w_out, *final_g;
    float* out; unsigned char* ws;
};

__device__ __forceinline__ bf16_t f2bf(float f) { unsigned u = __float_as_uint(f); u += 0x7fffu + ((u >> 16) & 1u); return (bf16_t)(u >> 16); }
__device__ __forceinline__ float bf2f(bf16_t b) { return __uint_as_float(((unsigned)b) << 16); }
__device__ __forceinline__ float bflo(unsigned w) { return __uint_as_float(w << 16); }
__device__ __forceinline__ float bfhi(unsigned w) { return __uint_as_float(w & 0xffff0000u); }
__device__ __forceinline__ unsigned cvt_pk_bf16(float lo, float hi) { unsigned r; asm volatile("v_cvt_pk_bf16_f32 %0, %1, %2" : "=v"(r) : "v"(lo), "v"(hi)); return r; }
__device__ __forceinline__ float siluf(float v) { return v / (1.f + __expf(-v)); }
__device__ __forceinline__ float sigmf(float v) { return 1.f / (1.f + __expf(-v)); }
__device__ __forceinline__ int lane_id() { int l = __builtin_amdgcn_mbcnt_hi(~0u, __builtin_amdgcn_mbcnt_lo(~0u, 0u)); asm volatile("" : "+v"(l)); return l; }
template <int K> __device__ __forceinline__ float swz_xor(float v) { return __uint_as_float((unsigned)__builtin_amdgcn_ds_swizzle((int)__float_as_uint(v), (K << 10) | 0x1f)); }
__device__ __forceinline__ float half_swap_sum(float v) { auto rr = __builtin_amdgcn_permlane32_swap(__float_as_uint(v), __float_as_uint(v), false, false); return __uint_as_float(rr[0]) + __uint_as_float(rr[1]); }
__device__ __forceinline__ float half_swap_max(float v) { auto rr = __builtin_amdgcn_permlane32_swap(__float_as_uint(v), __float_as_uint(v), false, false); return fmaxf(__uint_as_float(rr[0]), __uint_as_float(rr[1])); }
__device__ __forceinline__ float wave_sum(float v) {
    v += swz_xor<1>(v); v += swz_xor<2>(v); v += swz_xor<4>(v); v += swz_xor<8>(v); v += swz_xor<16>(v);
    return half_swap_sum(v);
}
__device__ __forceinline__ float wave_max(float v) {
    v = fmaxf(v, swz_xor<1>(v)); v = fmaxf(v, swz_xor<2>(v)); v = fmaxf(v, swz_xor<4>(v)); v = fmaxf(v, swz_xor<8>(v)); v = fmaxf(v, swz_xor<16>(v));
    return half_swap_max(v);
}

#define XB_TMO      128
#define XB_XCNT(j)  (256  + 64 * (j))
#define XB_XSUB(j)  (1280 + 64 * (j))
#define XB_XGEN(j)  (2304 + 64 * (j))
#define XB_TOP      3328
#define XB_TOPGEN   3392
#define XB_SPIN_CAP (1u << 24)
__device__ __forceinline__ unsigned xb_ld(unsigned* p)              { return __hip_atomic_load(p, __ATOMIC_RELAXED, __HIP_MEMORY_SCOPE_AGENT); }
__device__ __forceinline__ unsigned xb_add(unsigned* p, unsigned v) { return __hip_atomic_fetch_add(p, v, __ATOMIC_RELAXED, __HIP_MEMORY_SCOPE_AGENT); }
__device__ __forceinline__ unsigned xb_xcc_id() { return (unsigned)__builtin_amdgcn_s_getreg((3 << 11) | 20) & 0xFu; }
#define XB_SPIN(cond, bar) do { unsigned _sp = 0; while (cond) { __builtin_amdgcn_s_sleep(1); \
    if ((++_sp & 255u) == 0u) { if (xb_ld(&(bar)[XB_TMO])) break; if (_sp > XB_SPIN_CAP) { atomicAdd(&(bar)[XB_TMO], 1u); break; } } } } while (0)
struct XcdBarrier { unsigned* bar; unsigned x; volatile LAS unsigned* st; };
__device__ __forceinline__ void xcd_barrier_complete(unsigned* bar, unsigned x, unsigned& nloc, unsigned& nx) {
    const unsigned G = gridDim.x * gridDim.y * gridDim.z;
    unsigned sum, cnt, mine, sp = 0u;
    for (;;) {
        sum = 0u; cnt = 0u; mine = 0u;
#pragma unroll
        for (unsigned j = 0; j < 16; ++j) { const unsigned c = xb_ld(&bar[XB_XCNT(j)]); sum += c; cnt += (c > 0u) ? 1u : 0u; mine = (j == x) ? c : mine; }
        if (sum == G) break;
        __builtin_amdgcn_s_sleep(1);
        if ((++sp & 255u) == 0u) { if (xb_ld(&bar[XB_TMO])) break; if (sp > XB_SPIN_CAP) { atomicAdd(&bar[XB_TMO], 1u); break; } }
    }
    nloc = mine > 0u ? mine : 1u; nx = cnt > 0u ? cnt : 1u;
}
__device__ __forceinline__ void xcd_barrier(const XcdBarrier& b, const int wid) {
    const bool leader = (wid == 0) && (lane_id() == 0);
    asm volatile("s_waitcnt vmcnt(0)" ::: "memory");
    __syncthreads();
    if (leader) {
        unsigned* bar = b.bar;
        __builtin_amdgcn_s_waitcnt(0);
        unsigned nloc = b.st[0], nx = b.st[1];
        if (nloc == 0u) { xcd_barrier_complete(bar, b.x, nloc, nx); b.st[0] = nloc; b.st[1] = nx; }
        const unsigned old = xb_add(&bar[XB_XSUB(b.x)], 1u);
        const unsigned gen = old / nloc;
        if (old + 1u == (gen + 1u) * nloc) {
            __builtin_amdgcn_fence(__ATOMIC_RELEASE, "agent");
            asm volatile("s_waitcnt vmcnt(0)" ::: "memory");
            const unsigned og = xb_add(&bar[XB_TOP], 1u);
            const unsigned tg = og / nx;
            if (og + 1u == (tg + 1u) * nx) xb_add(&bar[XB_TOPGEN], 1u);
            else XB_SPIN(xb_ld(&bar[XB_TOPGEN]) == tg, bar);
            __builtin_amdgcn_fence(__ATOMIC_ACQUIRE, "agent");
            xb_add(&bar[XB_XGEN(b.x)], 1u);
            asm volatile("s_waitcnt vmcnt(0)" ::: "memory");
        } else {
            XB_SPIN(xb_ld(&bar[XB_XGEN(b.x)]) == gen, bar);
            __builtin_amdgcn_fence(__ATOMIC_ACQUIRE, "agent");
            asm volatile("s_waitcnt vmcnt(0)" ::: "memory");
        }
    }
    __syncthreads();
}

namespace pg8 {
constexpr int BM = 256, BK = 64, HALF = 128, HTB = HALF * BK * 2  , NXCD = 8, WGM = 8;
__host__ __device__ __forceinline__ int lds_byte(int r, int c) { const int st = (r >> 4) * 2 + (c >> 5), rr = r & 15, cc = c & 31, ob = rr * 64 + cc * 2; return st * 1024 + (ob ^ (((ob >> 9) & 1) << 5)); }
__host__ __device__ __forceinline__ void stage_rc(int b, int& R, int& C) { const int st = b / 1024, sb = b % 1024, swz = sb ^ (((sb >> 9) & 1) << 5); R = (st >> 1) * 16 + swz / 64; C = (st & 1) * 32 + (swz % 64) / 2; }
__host__ __device__ __forceinline__ int perm32(int rho) { const int n = rho >> 4, i = rho & 15; return 8 * (i >> 2) + 4 * n + (i & 3); }

struct Unit { int pm, pn; };
struct Gemm { const bf16_t* A; const bf16_t* Bt; int lda, ldb, K, a_koff_pn; };

struct StaticOrder {
    int nM, nN, nwg, G, c, extra;
    __device__ void init(int nM_, int nN_, int G_, int c_, int extra_) { nM = nM_; nN = nN_; nwg = nM * nN; G = G_; c = c_; extra = extra_; }
    __device__ bool next(int i, Unit& u) const {
        const long L = (long)i * G + c; if (L >= nwg + extra) return false;
        if (L >= nwg) { u.pm = nM + (int)(L - nwg); u.pn = nN - 1; return true; }
        int wgid = (int)L; { const int q = nwg / NXCD, r = nwg % NXCD, xcd = wgid % NXCD, off = wgid / NXCD; wgid = (xcd < r ? xcd * (q + 1) : r * (q + 1) + (xcd - r) * q) + off; }
        const int nig = WGM * nN, gid = wgid / nig, fm = gid * WGM, gsz = (nM - fm) < WGM ? (nM - fm) : WGM;
        u.pm = fm + ((wgid % nig) % gsz); u.pn = (wgid % nig) / gsz; return true;
    }
};

typedef f32x4 Acc[2][2][4][2];

template <class Epi>
__device__ __forceinline__ void gemm_phase(LAS unsigned char* lds, const Gemm g, const StaticOrder& S, const Epi& E, const int wid) {
    const int lane = lane_id(), tid = wid * 64 + lane, wr = wid >> 2, wc = wid & 3, fr = lane & 15, fq = lane >> 4;
    const int K = g.K, nt = K / BK;
    unsigned voffA[2], voffB[2];
#pragma unroll
    for (int i = 0; i < 2; ++i) { int R, C; stage_rc(tid * 16 + i * 8192, R, C); const int Rb = (R & ~31) + perm32(R & 31);
        voffA[i] = (unsigned)(R * g.lda + C) * 2u; voffB[i] = (unsigned)(Rb * g.ldb + C) * 2u; }
    const size_t kstep = (size_t)(BK * 2);
    const size_t hstepA = (size_t)HALF * g.lda * 2, hstepB = (size_t)HALF * g.ldb * 2;
    const size_t tstepA = 2 * hstepA, tstepB = 2 * hstepB;
    const unsigned ldsw = (unsigned)wid * 1024u;
    const int aoff = lds_byte(wr * 64 + fr, fq * 8), boff = lds_byte(wc * 32 + fr, fq * 8);
#define PG8_SA(b, h) (((b) * 2 + (h)) * HTB)
#define PG8_SB(b, h) ((4 + (b) * 2 + (h)) * HTB)
#define PG8_STAGE(bufoff, gbase, voff) do { _Pragma("unroll") for (int _i = 0; _i < 2; ++_i) \
        __builtin_amdgcn_global_load_lds((const unsigned*)((const char*)(gbase) + (voff)[_i]), (LAS unsigned*)(lds + (bufoff) + ldsw + _i * 8192), 16, 0, 0); } while (0)
#define PG8_LDA(dst, b, h) do { _Pragma("unroll") for (int m = 0; m < 4; ++m) _Pragma("unroll") for (int k = 0; k < 2; ++k) dst[m][k] = *(const LAS bf16x8*)(lds + PG8_SA(b, h) + aoff + m * 2048 + k * 1024); } while (0)
#define PG8_LDB(dst, b, h) do { _Pragma("unroll") for (int n = 0; n < 2; ++n) _Pragma("unroll") for (int k = 0; k < 2; ++k) dst[n][k] = *(const LAS bf16x8*)(lds + PG8_SB(b, h) + boff + n * 2048 + k * 1024); } while (0)
#define PG8_MMA(ai, bj, At, Bt) do { __builtin_amdgcn_s_setprio(1); _Pragma("unroll") for (int m = 0; m < 4; ++m) _Pragma("unroll") for (int n = 0; n < 2; ++n) _Pragma("unroll") for (int k = 0; k < 2; ++k) \
        acc[ai][bj][m][n] = __builtin_amdgcn_mfma_f32_16x16x32_bf16(Bt[n][k], At[m][k], acc[ai][bj][m][n], 0, 0, 0); __builtin_amdgcn_s_setprio(0); } while (0)
#define PG8_WAIT_V(n) asm volatile("s_waitcnt vmcnt(" #n ")" ::: "memory")
#define PG8_WAIT_L(n) asm volatile("s_waitcnt lgkmcnt(" #n ")" ::: "memory")
#define PG8_BAR __builtin_amdgcn_s_barrier()
#define PG8_SCHED __builtin_amdgcn_sched_barrier(0)
    Unit cur, nxt; int ui = 0;
    if (!S.next(0, cur)) return;
    Acc acc;
#pragma unroll
    for (int a = 0; a < 2; ++a)
#pragma unroll
        for (int b = 0; b < 2; ++b)
#pragma unroll
            for (int m = 0; m < 4; ++m)
#pragma unroll
                for (int n = 0; n < 2; ++n) acc[a][b][m][n] = (f32x4){0.f, 0.f, 0.f, 0.f};
    bf16x8 At[4][2], B0[2][2], B1[2][2];
    const char* cA = (const char*)g.A + (size_t)cur.pm * tstepA + (size_t)cur.pn * g.a_koff_pn * 2; const char* cB = (const char*)g.Bt + (size_t)cur.pn * tstepB;
    PG8_STAGE(PG8_SB(0, 0), cB, voffB); PG8_STAGE(PG8_SB(0, 1), cB + hstepB, voffB); PG8_STAGE(PG8_SA(0, 0), cA, voffA); PG8_STAGE(PG8_SA(0, 1), cA + hstepA, voffA);
    if (wr == 1) PG8_BAR;
    PG8_WAIT_V(2); PG8_BAR;
    PG8_STAGE(PG8_SB(1, 0), cB + kstep, voffB); PG8_STAGE(PG8_SA(1, 0), cA + kstep, voffA); PG8_STAGE(PG8_SB(1, 1), cB + hstepB + kstep, voffB);
    PG8_WAIT_V(6); PG8_BAR;
    for (;;) {
        const bool has_next = S.next(ui + 1, nxt);
        const char* nA = has_next ? (const char*)g.A + (size_t)nxt.pm * tstepA + (size_t)nxt.pn * g.a_koff_pn * 2 : cA; const char* nB = has_next ? (const char*)g.Bt + (size_t)nxt.pn * tstepB : cB;
        for (int t = 0; t < nt; t += 2) {
            const bool last = (t == nt - 2);
            const char* a1 = cA + (size_t)(t + 1) * kstep;
            const char* a2 = last ? nA : cA + (size_t)(t + 2) * kstep; const char* b2 = last ? nB : cB + (size_t)(t + 2) * kstep;
            const char* a3 = a2 + kstep; const char* b3 = b2 + kstep;
            PG8_LDB(B0, 0, 0); PG8_LDB(B1, 0, 1); PG8_SCHED; PG8_LDA(At, 0, 0); PG8_STAGE(PG8_SA(1, 1), a1 + hstepA, voffA);
            PG8_WAIT_V(8); PG8_WAIT_L(0); PG8_BAR; PG8_MMA(0, 0, At, B0); PG8_MMA(0, 1, At, B1); PG8_BAR; PG8_SCHED;
            PG8_LDA(At, 0, 1); PG8_STAGE(PG8_SB(0, 0), b2, voffB); PG8_STAGE(PG8_SB(0, 1), b2 + hstepB, voffB); PG8_STAGE(PG8_SA(0, 0), a2, voffA);
            PG8_WAIT_V(8); PG8_WAIT_L(0); PG8_BAR; PG8_MMA(1, 0, At, B0); PG8_MMA(1, 1, At, B1); PG8_BAR; PG8_SCHED;
            PG8_LDB(B0, 1, 0); PG8_LDB(B1, 1, 1); PG8_SCHED; PG8_LDA(At, 1, 0); PG8_STAGE(PG8_SA(0, 1), a2 + hstepA, voffA);
            PG8_WAIT_V(8); PG8_WAIT_L(0); PG8_BAR; PG8_MMA(0, 0, At, B0); PG8_MMA(0, 1, At, B1); PG8_BAR; PG8_SCHED;
            PG8_LDA(At, 1, 1); PG8_STAGE(PG8_SB(1, 0), b3, voffB); PG8_STAGE(PG8_SB(1, 1), b3 + hstepB, voffB); PG8_STAGE(PG8_SA(1, 0), a3, voffA);
            PG8_WAIT_V(8); PG8_WAIT_L(0); PG8_BAR; PG8_MMA(1, 0, At, B0); PG8_MMA(1, 1, At, B1); PG8_BAR; PG8_SCHED;
        }
        if (wr == 0) PG8_BAR;
        E(acc, cur, wr, wc, fr, fq);
        if (!has_next) break;
#pragma unroll
        for (int a = 0; a < 2; ++a)
#pragma unroll
            for (int b = 0; b < 2; ++b)
#pragma unroll
                for (int m = 0; m < 4; ++m)
#pragma unroll
                    for (int n = 0; n < 2; ++n) acc[a][b][m][n] = (f32x4){0.f, 0.f, 0.f, 0.f};
        cur = nxt; cA = nA; cB = nB; ++ui;
        if (wr == 1) PG8_BAR;
    }
    PG8_WAIT_V(0);
    PG8_BAR;
#undef PG8_SA
#undef PG8_SB
#undef PG8_STAGE
#undef PG8_LDA
#undef PG8_LDB
#undef PG8_MMA
#undef PG8_WAIT_V
#undef PG8_WAIT_L
#undef PG8_BAR
#undef PG8_SCHED
}

#define EPI_FOREACH(...) _Pragma("unroll") for (int ai = 0; ai < 2; ++ai) _Pragma("unroll") for (int m = 0; m < 4; ++m) { const int row = u.pm * BM + ai * HALF + wr * 64 + m * 16 + fr; \
        _Pragma("unroll") for (int bj = 0; bj < 2; ++bj) { const int ct = bj * HALF + wc * 32 + 8 * fq; const f32x4 v0 = acc[ai][bj][m][0], v1 = acc[ai][bj][m][1]; __VA_ARGS__ } }
__device__ __forceinline__ u32x4 pack8(const f32x4 a, const f32x4 b) { u32x4 w; w.x = cvt_pk_bf16(a[0], a[1]); w.y = cvt_pk_bf16(a[2], a[3]); w.z = cvt_pk_bf16(b[0], b[1]); w.w = cvt_pk_bf16(b[2], b[3]); return w; }
__device__ __forceinline__ void unpack8(const u32x4 w, f32x4& a, f32x4& b) { a = (f32x4){bflo(w.x), bfhi(w.x), bflo(w.y), bfhi(w.y)}; b = (f32x4){bflo(w.z), bfhi(w.z), bflo(w.w), bfhi(w.w)}; }
__device__ __forceinline__ f32x4 act4(f32x4 v, int mode) {
    f32x4 o;
#pragma unroll
    for (int j = 0; j < 4; ++j) { const float s = __builtin_amdgcn_rcpf(1.f + __expf(-v[j])); o[j] = mode == 1 ? v[j] * s : s; }
    return o;
}
struct Epi1 {
    bf16_t *U, *SGP, *QA, *SGM, *GMP, *GMM; float* KVA; const float* b_gate;
    __device__ __forceinline__ void operator()(const Acc& acc, const Unit& u, int wr, int wc, int fr, int fq) const {
        const int pn = u.pn;
        if (pn == 25) { EPI_FOREACH({ float* p = KVA + (size_t)row * 256 + ct; *(f32x4*)p = v0; *(f32x4*)(p + 4) = v1; }) return; }
        bf16_t* base; int ld, c0, mode = 0; const float* bias = nullptr;
        if (pn < 4) { base = U; ld = 1024; c0 = pn * 256; }
        else if (pn < 8) { base = SGP; ld = 1024; c0 = (pn - 4) * 256; mode = 1; }
        else if (pn < 9) { base = QA; ld = 256; c0 = 0; }
        else if (pn < 17) { base = SGM; ld = 2048; c0 = (pn - 9) * 256; mode = 1; }
        else if (pn < 21) { base = GMP; ld = 1024; c0 = (pn - 17) * 256; mode = 2; bias = b_gate + c0; }
        else { base = GMM; ld = 1024; c0 = (pn - 21) * 256; mode = 2; bias = b_gate + 1024 + c0; }
        if (mode == 0) { EPI_FOREACH({ *(u32x4*)(base + (size_t)row * ld + c0 + ct) = pack8(v0, v1); }) }
        else if (mode == 1) { EPI_FOREACH({ *(u32x4*)(base + (size_t)row * ld + c0 + ct) = pack8(act4(v0, 1), act4(v1, 1)); }) }
        else { EPI_FOREACH({ const f32x4 b0 = *(const f32x4*)(bias + ct), b1 = *(const f32x4*)(bias + ct + 4);
                             *(u32x4*)(base + (size_t)row * ld + c0 + ct) = pack8(act4(v0 + b0, 2), act4(v1 + b1, 2)); }) }
    }
};
struct Epi2 {
    const float* pool_scale; const bf16_t* SGP; bf16_t* P1;
    __device__ __forceinline__ void operator()(const Acc& acc, const Unit& u, int wr, int wc, int fr, int fq) const {
        EPI_FOREACH({ const int col = u.pn * 256 + ct; const size_t o = (size_t)row * 1024 + col; f32x4 g0, g1; unpack8(*(const u32x4*)(SGP + o), g0, g1);
            const f32x4 s0 = *(const f32x4*)(pool_scale + col), s1 = *(const f32x4*)(pool_scale + col + 4);
            *(u32x4*)(P1 + o) = pack8(v0 * s0 * g0, v1 * s1 * g1); })
    }
};
struct Epi3a {
    const bf16_t* GMP; float* T;
    __device__ __forceinline__ void operator()(const Acc& acc, const Unit& u, int wr, int wc, int fr, int fq) const {
        EPI_FOREACH({ const size_t o = (size_t)row * 1024 + u.pn * 256 + ct; f32x4 g0, g1; unpack8(*(const u32x4*)(GMP + o), g0, g1);
            *(f32x4*)(T + o) = v0 * g0; *(f32x4*)(T + o + 4) = v1 * g1; })
    }
};
struct Epi3b {
    const bf16_t* GMM; const float* T; bf16_t* Z;
    __device__ __forceinline__ void operator()(const Acc& acc, const Unit& u, int wr, int wc, int fr, int fq) const {
        EPI_FOREACH({ const size_t o = (size_t)row * 1024 + u.pn * 256 + ct; f32x4 g0, g1; unpack8(*(const u32x4*)(GMM + o), g0, g1);
            const f32x4 t0 = *(const f32x4*)(T + o), t1 = *(const f32x4*)(T + o + 4);
            *(u32x4*)(Z + o) = pack8(t0 + v0 * g0, t1 + v1 * g1); })
    }
};
struct Epi4 {
    const float* x; const float* ada; float* XN;
    __device__ __forceinline__ void operator()(const Acc& acc, const Unit& u, int wr, int wc, int fr, int fq) const {
        const float* gate = ada + ((u.pm * BM) / S) * 3072 + 2048;
        EPI_FOREACH({ const int col = u.pn * 256 + ct; const size_t o = (size_t)row * 1024 + col;
            const f32x4 g0 = *(const f32x4*)(gate + col), g1 = *(const f32x4*)(gate + col + 4), x0 = *(const f32x4*)(x + o), x1 = *(const f32x4*)(x + o + 4);
            *(f32x4*)(XN + o) = x0 + g0 * v0; *(f32x4*)(XN + o + 4) = x1 + g1 * v1; })
    }
};
}

__device__ __forceinline__ void transpose_item(const float* __restrict__ src, int ld, int K, int N, bf16_t* __restrict__ dst, int mode, const float* __restrict__ kscale, int item, float* tile, const int tid) {
    const int tilesN = N / 64, tn = item % tilesN, tk = item / tilesN;
#pragma unroll 1
    for (int i = tid; i < 4096; i += NTHREADS) {
        const int kk = i >> 6, nn = i & 63, n = tn * 64 + nn; int col;
        if (mode == 0) col = n;
        else if (mode == 1) col = n < C_GM ? n : (n < C_KV ? n + 192 : (n < C_KV + 192 ? n - C_KV + 2304 : -1));
        else if (mode == 2) col = (n >> 7) * 256 + 128 + (n & 127);
        else col = (n / 64) * 192 + 128 + (n % 64);
        const int k = tk * 64 + kk;
        const int ks = (mode == 2) ? ((k & ~15) + 8 * ((k & 7) >> 2) + 4 * ((k >> 3) & 1) + (k & 3)) : k;
        tile[kk * 65 + nn] = col >= 0 ? src[(size_t)ks * ld + col] * (kscale ? kscale[k] : 1.f) : 0.f;
    }
    __syncthreads();
#pragma unroll 1
    for (int i = tid; i < 4096; i += NTHREADS) {
        const int nn = i >> 6, kk = i & 63, n = tn * 64 + nn; size_t drow;
        if (mode == 3) drow = (size_t)(n / 64) * 192 + 128 + (n % 64); else drow = n;
        dst[drow * K + tk * 64 + kk] = f2bf(tile[kk * 65 + nn]);
    }
    __syncthreads();
}
__device__ __forceinline__ void p0_prep(const Params& P, unsigned char* lds, const int wave) {
    unsigned char* ws = P.ws; float* fl = (float*)lds;
    const int lane = lane_id(), tid = wave * 64 + lane, bid = blockIdx.x, G = gridDim.x;
    float* ADA = (float*)(ws + WS_ADA);
    if (bid < 96) {
        float* sl = fl;
        float* red = fl + 17 * 1024;
        for (int i = tid; i < 17 * 1024; i += NTHREADS) { const int r = i >> 10, k = i & 1023; sl[i] = siluf(r < 16 ? P.c[r * D + k] : P.c_ctx[k]); }
        __syncthreads();
        const int j = bid * 32 + (lane & 31), kb = wave * 128 + (lane >> 5);
        float acc[17];
#pragma unroll
        for (int r = 0; r < 17; ++r) acc[r] = 0.f;
#pragma unroll 4
        for (int i = 0; i < 64; ++i) { const int k = kb + 2 * i; const float w = P.ada_w[(size_t)k * 3072 + j];
#pragma unroll
            for (int r = 0; r < 17; ++r) acc[r] += sl[r * 1024 + k] * w; }
#pragma unroll
        for (int r = 0; r < 17; ++r) { acc[r] = half_swap_sum(acc[r]); if (lane < 32) red[(wave * 17 + r) * 32 + lane] = acc[r]; }
        __syncthreads();
        for (int i = tid; i < 17 * 32; i += NTHREADS) { const int r = i >> 5, jj = i & 31; float s = 0.f;
            for (int w = 0; w < 8; ++w) s += red[(w * 17 + r) * 32 + jj];
            ADA[r * 3072 + bid * 32 + jj] = s + P.ada_b[bid * 32 + jj]; }
        __syncthreads();
    }
    if (bid == 96) { float* rope = (float*)(ws + WS_ROPE);
        for (int i = tid; i < 64 * 16; i += NTHREADS) { const int pos = i >> 4, f = i & 15; const float a = (float)pos * powf(10000.f, -(float)f / 16.f); rope[i * 2] = cosf(a); rope[i * 2 + 1] = sinf(a); } }
    constexpr int I_WIN = (N1 / 64) * 16, I_POOL = 4 * 16, I_PP = 16 * 16, I_PM = 16 * 32, I_OUT = 16 * 16, I_VB = 32 * 2, I_QR = 16 * 4;
    constexpr int NITEMS = I_WIN + I_POOL + I_PP + I_PM + I_OUT + I_VB + I_QR;
    for (int it = (bid + G - 97 % G) % G; it < NITEMS; it += G) {
        int r = it;
        if (r < I_WIN) { transpose_item(P.w_in, INW, 1024, N1, (bf16_t*)(ws + WS_WINT), 1, nullptr, r, fl, tid); continue; } r -= I_WIN;
        if (r < I_POOL) { const int g = r / 16; transpose_item(P.w_pool + (size_t)g * 65536, 256, 256, 256, (bf16_t*)(ws + WS_WPOOL) + (size_t)g * 65536, 0, nullptr, r % 16, fl, tid); continue; } r -= I_POOL;
        if (r < I_PP) { transpose_item(P.w_pp, 1024, 1024, 1024, (bf16_t*)(ws + WS_WPP), 0, nullptr, r, fl, tid); continue; } r -= I_PP;
        if (r < I_PM) { transpose_item(P.w_pm, 1024, 2048, 1024, (bf16_t*)(ws + WS_WPM), 0, nullptr, r, fl, tid); continue; } r -= I_PM;
        if (r < I_OUT) { transpose_item(P.w_out, 1024, 1024, 1024, (bf16_t*)(ws + WS_WOUT), 0, nullptr, r, fl, tid); continue; } r -= I_OUT;
        if (r < I_VB) { transpose_item(P.w_kvb, 4096, 128, 2048, (bf16_t*)(ws + WS_WVBT), 2, nullptr, r, fl, tid); continue; } r -= I_VB;
        transpose_item(P.w_qb, 3072, 256, 1024, (bf16_t*)(ws + WS_WQT), 3, P.q_norm_g, r, fl, tid);
    }
    for (int it = bid; it < 64; it += G) {
        const int h = it >> 2, k0 = (it & 3) * 64;
        float* As = fl;
        float* Bs = fl + 64 * 129;
        for (int i = tid; i < 64 * 128; i += NTHREADS) { const int kk = i >> 7, j = i & 127; As[kk * 129 + j] = P.w_qb[(size_t)(k0 + kk) * 3072 + h * 192 + j]; }
        for (int i = tid; i < 128 * 128; i += NTHREADS) { const int l = i >> 7, j = i & 127; Bs[l * 129 + j] = P.w_kvb[(size_t)l * 4096 + h * 256 + j]; }
        __syncthreads();
        const int kk = tid & 63, lb = tid >> 6; const float qg = P.q_norm_g[k0 + kk];
#pragma unroll 1
        for (int i = 0; i < 16; ++i) { const int l = lb + 8 * i; float a = 0.f;
#pragma unroll 8
            for (int j = 0; j < 128; ++j) a += As[kk * 129 + j] * Bs[l * 129 + j];
            ((bf16_t*)(ws + WS_WQT))[((size_t)h * 192 + l) * 256 + k0 + kk] = f2bf(a * qg); }
        __syncthreads();
    }
}

__device__ __forceinline__ void p1_h(const Params& P, const int wave) {
    const int lane = lane_id(), gw = blockIdx.x * NWAVES + wave, NGW = gridDim.x * NWAVES;
    const float* ADA = (const float*)(P.ws + WS_ADA); bf16_t* H = (bf16_t*)P.out;
    for (int row = gw; row < MT; row += NGW) {
        const bool isx = row < M; const float* src = isx ? P.x + (size_t)row * D : P.ctx + (size_t)(row - M) * D;
        const float* sh = ADA + (isx ? row / S : 16) * 3072, *sc = sh + 1024;
        f32x4 v[4]; float ss = 0.f;
#pragma unroll
        for (int j = 0; j < 4; ++j) { v[j] = *(const f32x4*)(src + 256 * j + 4 * lane); ss += v[j][0] * v[j][0] + v[j][1] * v[j][1] + v[j][2] * v[j][2] + v[j][3] * v[j][3]; }
        const float rinv = rsqrtf(wave_sum(ss) * (1.f / D) + EPS);
#pragma unroll
        for (int j = 0; j < 4; ++j) { const int c0 = 256 * j + 4 * lane; const f32x4 g = *(const f32x4*)(P.norm_g + c0), s1 = *(const f32x4*)(sc + c0), s0 = *(const f32x4*)(sh + c0);
            const f32x4 o = v[j] * rinv * g * (s1 + 1.f) + s0; u32x2 w; w.x = cvt_pk_bf16(o[0], o[1]); w.y = cvt_pk_bf16(o[2], o[3]);
            *(u32x2*)(H + (size_t)row * D + c0) = w; }
    }
}

__device__ __forceinline__ void p3_thin(const Params& P, const int wave) {
    const int lane = lane_id(), gw = blockIdx.x * NWAVES + wave, NGW = gridDim.x * NWAVES;
    const float* KVA = (const float*)(P.ws + WS_KVA); const float* rope = (const float*)(P.ws + WS_ROPE); bf16_t* KC = (bf16_t*)(P.ws + WS_KC);
    for (int t = gw; t < MT; t += NGW) {
        const bool isx = t < M; const int b = isx ? t / S : (t - M) / CTX, pos = isx ? t % S : (t - M) % CTX, key = isx ? pos : S + pos;
        const float* src = KVA + (size_t)t * 256;
        const float c0 = src[lane], c1 = src[64 + lane];
        const float rinv = rsqrtf(wave_sum(c0 * c0 + c1 * c1) * (1.f / KVL) + EPS);
        bf16_t* dst = KC + ((size_t)b * NKEY + key) * QKD;
        dst[lane] = f2bf(c0 * rinv * P.kv_norm_g[lane]); dst[64 + lane] = f2bf(c1 * rinv * P.kv_norm_g[64 + lane]);
        float kr = src[128 + lane];
        if (isx) {
            const int half = lane >> 5, w = lane & 31, i = w & 15, p = half ? (pos & 63) : (pos >> 6);
            const float other = swz_xor<16>(kr);
            const float cs = rope[(p * 16 + i) * 2], sn = rope[(p * 16 + i) * 2 + 1];
            kr = (w < 16) ? kr * cs - other * sn : kr * cs + other * sn;
        }
        dst[128 + lane] = f2bf(kr);
    }
    const bf16_t* U = (const bf16_t*)(P.ws + WS_U); bf16_t* Dp = (bf16_t*)P.out;
    for (int t = gw; t < M; t += NGW) {
        const int pos = t % S;
#pragma unroll
        for (int g = 0; g < 4; ++g) {
            const int col = g * 256 + 4 * lane, hw = 1 << g, lo = max(pos - hw, 0), hi = min(pos + hw, S);
            f32x4 s = {0.f, 0.f, 0.f, 0.f};
            for (int p = lo; p < hi; ++p) { const u32x2 w = *(const u32x2*)(U + (size_t)(t - pos + p) * 1024 + col); s += (f32x4){bflo(w.x), bfhi(w.x), bflo(w.y), bfhi(w.y)}; }
            const u32x2 w = *(const u32x2*)(U + (size_t)t * 1024 + col); const f32x4 uu = {bflo(w.x), bfhi(w.x), bflo(w.y), bfhi(w.y)};
            const f32x4 d = s * (1.f / (float)(hi - lo)) - uu; u32x2 o; o.x = cvt_pk_bf16(d[0], d[1]); o.y = cvt_pk_bf16(d[2], d[3]);
            *(u32x2*)(Dp + (size_t)t * 1024 + col) = o;
        }
    }
}

__device__ __forceinline__ void p5_attn_simple(const Params& P, unsigned char* lds, const int wave) {
    const int lane = lane_id(), gw = blockIdx.x * NWAVES + wave, NGW = gridDim.x * NWAVES;
    float* base = (float*)lds + wave * 3072;
    float* qs = base, *ol = base + 192, *qa = base + 320, *ps = base + 576;
    const bf16_t* QA = (const bf16_t*)(P.ws + WS_QA); const bf16_t* WqT = (const bf16_t*)(P.ws + WS_WQT); const bf16_t* KC = (const bf16_t*)(P.ws + WS_KC);
    const bf16_t* WvbT = (const bf16_t*)(P.ws + WS_WVBT); const float* rope = (const float*)(P.ws + WS_ROPE); bf16_t* A2 = (bf16_t*)(P.ws + WS_SGM);
    for (int gq = gw; gq < NB * NH * S; gq += NGW) {
        const int s = gq % S, h = (gq / S) % NH, b = gq / (S * NH), t = b * S + s;
        float ss = 0.f;
        for (int i = 0; i < 4; ++i) { const float v = bf2f(QA[(size_t)t * QL + lane + 64 * i]); qa[lane + 64 * i] = v; ss += v * v; }
        const float rinv = rsqrtf(wave_sum(ss) * (1.f / QL) + EPS);
        for (int i = 0; i < 3; ++i) { const int r = lane + 64 * i; const u32x4* wr = (const u32x4*)(WqT + ((size_t)h * QKD + r) * QL);
            float acc = 0.f;
            for (int k8 = 0; k8 < QL / 8; ++k8) { const u32x4 w = wr[k8]; const float* q = qa + k8 * 8;
                acc += q[0] * bflo(w.x) + q[1] * bfhi(w.x) + q[2] * bflo(w.y) + q[3] * bfhi(w.y) + q[4] * bflo(w.z) + q[5] * bfhi(w.z) + q[6] * bflo(w.w) + q[7] * bfhi(w.w); }
            qs[r] = acc * rinv; }
        if (lane < 32) { const int half = lane >> 4, i = lane & 15, p = half ? (s & 63) : (s >> 6);
            const float a = qs[128 + half * 32 + i], bb = qs[128 + half * 32 + 16 + i];
            const float cs = rope[(p * 16 + i) * 2], sn = rope[(p * 16 + i) * 2 + 1];
            qs[128 + half * 32 + i] = a * cs - bb * sn; qs[128 + half * 32 + 16 + i] = bb * cs + a * sn; }
        for (int i = 0; i < 3; ++i) { const int r = lane + 64 * i; qs[r] = bf2f(f2bf(qs[r])); }
        const float scale = 0.07216878364870322f;
        const bf16_t* Kb = KC + (size_t)b * NKEY * QKD;
        float mx = -1e30f;
        for (int key = lane; key < NKEY; key += 64) {
            const u32x4* kr = (const u32x4*)(Kb + (size_t)key * QKD); float acc = 0.f;
            for (int c = 0; c < QKD / 8; ++c) { const u32x4 w = kr[c]; const float* q = qs + c * 8;
                acc += q[0] * bflo(w.x) + q[1] * bfhi(w.x) + q[2] * bflo(w.y) + q[3] * bfhi(w.y) + q[4] * bflo(w.z) + q[5] * bfhi(w.z) + q[6] * bflo(w.w) + q[7] * bfhi(w.w); }
            acc *= scale; ps[key] = acc; mx = fmaxf(mx, acc);
        }
        mx = wave_max(mx);
        float l = 0.f;
        for (int key = lane; key < NKEY; key += 64) { const float p = __expf(ps[key] - mx); l += p; ps[key] = bf2f(f2bf(p)); }
        l = wave_sum(l);
        float o0 = 0.f, o1 = 0.f;
        for (int key = 0; key < NKEY; ++key) { const unsigned v = *(const unsigned*)(Kb + (size_t)key * QKD + 2 * lane); const float p = ps[key]; o0 += p * bflo(v); o1 += p * bfhi(v); }
        ol[2 * lane] = bf2f(f2bf(o0 / l)); ol[2 * lane + 1] = bf2f(f2bf(o1 / l));
        for (int i = 0; i < 2; ++i) { const int v = lane + 64 * i; const u32x4* wr = (const u32x4*)(WvbT + ((size_t)h * VD + v) * KVL);
            float acc = 0.f;
            for (int k8 = 0; k8 < KVL / 8; ++k8) { const u32x4 w = wr[k8]; const float* q = ol + k8 * 8;
                acc += q[0] * bflo(w.x) + q[1] * bfhi(w.x) + q[2] * bflo(w.y) + q[3] * bfhi(w.y) + q[4] * bflo(w.z) + q[5] * bfhi(w.z) + q[6] * bflo(w.w) + q[7] * bfhi(w.w); }
            bf16_t* dst = A2 + (size_t)t * 2048 + h * VD + v; *dst = f2bf(acc * bf2f(*dst)); }
    }
}


namespace att {
using f32x16 = __attribute__((ext_vector_type(16))) float;
using s16x4  = __attribute__((ext_vector_type(4))) short;
constexpr float SCALE = 0.07216878364870322f;
constexpr float THR = 0.f;
constexpr int KVBLK = 64, NT = NKEY / KVBLK;
constexpr int KROW = 400;
constexpr int SHM_V = KVBLK * 128 * 2, SHM_K = KVBLK * KROW, V_OFF = 0, K_OFF = 2 * SHM_V;
static_assert(NT % 2 == 0 && K_OFF + 2 * SHM_K <= 131072, "attention LDS map");
#define SBAR() __builtin_amdgcn_sched_barrier(0)
__device__ __forceinline__ int crow(int r, int hi) { return (r & 3) + 8 * (r >> 2) + 4 * hi; }
__device__ __forceinline__ bf16x8 pack8r(const f32x16& a, int base) {
    u32x4 w = {cvt_pk_bf16(a[base + 0], a[base + 1]), cvt_pk_bf16(a[base + 2], a[base + 3]), cvt_pk_bf16(a[base + 4], a[base + 5]), cvt_pk_bf16(a[base + 6], a[base + 7])};
    return *reinterpret_cast<bf16x8*>(&w);
}
__device__ __forceinline__ void partialSM(f32x16& p0, f32x16& p1, float& m_reg, float& mn, float& alpha) {
    constexpr float C = SCALE * 1.4426950408889634f;
    float pmax = p0[0];
#pragma unroll
    for (int r = 1; r < 16; ++r) pmax = fmaxf(pmax, p0[r]);
#pragma unroll
    for (int r = 0; r < 16; ++r) pmax = fmaxf(pmax, p1[r]);
    { auto rr = __builtin_amdgcn_permlane32_swap(__float_as_uint(pmax), __float_as_uint(pmax), false, false);
      pmax = fmaxf(__uint_as_float(rr[0]), __uint_as_float(rr[1])); }
    if (__builtin_expect(__all(pmax - m_reg <= THR / SCALE), 1)) { mn = m_reg; alpha = 1.f; }
    else { mn = fmaxf(m_reg, pmax); alpha = __builtin_amdgcn_exp2f((m_reg - mn) * C); m_reg = mn; }
    const float mnC = -mn * C;
#pragma unroll
    for (int r = 0; r < 16; ++r) p0[r] = fmaf(p0[r], C, mnC);
#pragma unroll
    for (int r = 0; r < 16; ++r) p1[r] = fmaf(p1[r], C, mnC);
#pragma unroll
    for (int r = 0; r < 16; ++r) p0[r] = __builtin_amdgcn_exp2f(p0[r]);
}
__device__ __forceinline__ void finishSM(f32x16& p0, f32x16& p1, float alpha, float& l_reg, bf16x8& pa0, bf16x8& pa1, bf16x8& pa2, bf16x8& pa3) {
#pragma unroll
    for (int r = 0; r < 16; ++r) p1[r] = __builtin_amdgcn_exp2f(p1[r]);
    float ps = 0;
#pragma unroll
    for (int r = 0; r < 16; ++r) ps += p0[r];
#pragma unroll
    for (int r = 0; r < 16; ++r) ps += p1[r];
    { auto rr = __builtin_amdgcn_permlane32_swap(__float_as_uint(ps), __float_as_uint(ps), false, false);
      ps = __uint_as_float(rr[0]) + __uint_as_float(rr[1]); }
    l_reg = l_reg * alpha + ps;
#define PK4(P, BASE, OUT) do { unsigned a0 = cvt_pk_bf16(P[BASE + 0], P[BASE + 1]), a1 = cvt_pk_bf16(P[BASE + 2], P[BASE + 3]);   \
    unsigned b0 = cvt_pk_bf16(P[BASE + 4], P[BASE + 5]), b1 = cvt_pk_bf16(P[BASE + 6], P[BASE + 7]);                              \
    auto r0 = __builtin_amdgcn_permlane32_swap(a0, b0, false, false); auto r1 = __builtin_amdgcn_permlane32_swap(a1, b1, false, false); \
    u32x4 w = {r0[0], r1[0], r0[1], r1[1]}; OUT = *reinterpret_cast<bf16x8*>(&w); } while (0)
    PK4(p0, 0, pa0); PK4(p0, 8, pa1); PK4(p1, 0, pa2); PK4(p1, 8, pa3);
#undef PK4
}
__device__ __forceinline__ void qkt(f32x16& p0, f32x16& p1, const LAS unsigned char* Kl  , const bf16x8* qr) {
    p0 = f32x16{}; p1 = f32x16{};
#pragma unroll
    for (int d0 = 0; d0 < 12; ++d0) {
        const bf16x8 b0 = *(const LAS bf16x8*)(Kl + d0 * 32);
        const bf16x8 b1 = *(const LAS bf16x8*)(Kl + 32 * KROW + d0 * 32);
        p0 = __builtin_amdgcn_mfma_f32_32x32x16_bf16(b0, qr[d0], p0, 0, 0, 0);
        p1 = __builtin_amdgcn_mfma_f32_32x32x16_bf16(b1, qr[d0], p1, 0, 0, 0); }
}
__device__ __forceinline__ int v_st(int k, int c) { const int kk = (k & ~0xC) | ((k & 4) << 1) | ((k & 8) >> 1); return ((kk >> 3) * 4 + (c >> 5)) * 512 + ((kk & 7) * 32 + (c & 31)) * 2; }
__device__ __forceinline__ int v_rd_base(int lane) { return ((lane & 3) << 3) | (((lane >> 2) & 3) << 6) | (((lane >> 4) & 1) << 5) | (((lane >> 5) & 1) << 8); }
constexpr int v_rd_off(int d0, int ks, int half) { return d0 * 512 + ks * 4096 + half * 2048; }
template <int OFF> __device__ __forceinline__ s16x4 tr_read(int vb) {
    s16x4 r; asm volatile("ds_read_b64_tr_b16 %0, %1 offset:%2" : "=&v"(r) : "v"(vb), "i"(OFF) : "memory"); return r;
}
template <int D0> __device__ __forceinline__ void pv_one(f32x16& od, int vb, bf16x8 pa0, bf16x8 pa1, bf16x8 pa2, bf16x8 pa3) {
    const s16x4 l0 = tr_read<v_rd_off(D0, 0, 0)>(vb), h0 = tr_read<v_rd_off(D0, 0, 1)>(vb), l1 = tr_read<v_rd_off(D0, 1, 0)>(vb), h1 = tr_read<v_rd_off(D0, 1, 1)>(vb);
    const s16x4 l2 = tr_read<v_rd_off(D0, 2, 0)>(vb), h2 = tr_read<v_rd_off(D0, 2, 1)>(vb), l3 = tr_read<v_rd_off(D0, 3, 0)>(vb), h3 = tr_read<v_rd_off(D0, 3, 1)>(vb);
    asm volatile("s_waitcnt lgkmcnt(0)" ::: "memory"); SBAR();
#define PK(L, H) (bf16x8){L[0], L[1], L[2], L[3], H[0], H[1], H[2], H[3]}
    od = __builtin_amdgcn_mfma_f32_32x32x16_bf16(PK(l0, h0), pa0, od, 0, 0, 0);
    od = __builtin_amdgcn_mfma_f32_32x32x16_bf16(PK(l1, h1), pa1, od, 0, 0, 0);
    od = __builtin_amdgcn_mfma_f32_32x32x16_bf16(PK(l2, h2), pa2, od, 0, 0, 0);
    od = __builtin_amdgcn_mfma_f32_32x32x16_bf16(PK(l3, h3), pa3, od, 0, 0, 0);
#undef PK
}
__device__ __forceinline__ void pv_d0(f32x16* o, int vb, bf16x8 pa0, bf16x8 pa1, bf16x8 pa2, bf16x8 pa3) {
    pv_one<0>(o[0], vb, pa0, pa1, pa2, pa3); pv_one<1>(o[1], vb, pa0, pa1, pa2, pa3); pv_one<2>(o[2], vb, pa0, pa1, pa2, pa3); pv_one<3>(o[3], vb, pa0, pa1, pa2, pa3);
}

__device__ __forceinline__ void attn_unit(const bf16_t* __restrict__ QAu, const bf16_t* __restrict__ WqTh, const bf16_t* __restrict__ Kb, const bf16_t* __restrict__ WvbPh,
                                          const float* __restrict__ rope, bf16_t* __restrict__ A2u, const int pos0, LAS unsigned char* lds, const int wid, const int lane) {
    const int tid = wid * 64 + lane, r32 = lane & 31, hi = lane >> 5;
    bf16x8 qr[12];
    {
        bf16x8 qb[16]; float ss = 0.f;
        const bf16_t* qrow = QAu + (size_t)(wid * 32 + r32) * QL + hi * 8;
#pragma unroll
        for (int kk = 0; kk < 16; ++kk) qb[kk] = *(const bf16x8*)(qrow + kk * 16);
#pragma unroll
        for (int kk = 0; kk < 16; ++kk)
#pragma unroll
            for (int j = 0; j < 8; ++j) { const float v = bf2f((bf16_t)qb[kk][j]); ss += v * v; }
        ss = half_swap_sum(ss);
        const float rinv = rsqrtf(ss * (1.f / QL) + EPS);
        const int rsw = (r32 & ~0xC) | ((r32 & 4) << 1) | ((r32 & 8) >> 1);
        const int pos = pos0 + wid * 32 + r32;
#pragma unroll
        for (int t = 0; t < 6; ++t) {
            f32x16 acc = {};
            const bf16_t* wrow = WqTh + (size_t)(t * 32 + rsw) * QL + hi * 8;
#pragma unroll
            for (int kk = 0; kk < 16; ++kk) { const bf16x8 a = *(const bf16x8*)(wrow + kk * 16); acc = __builtin_amdgcn_mfma_f32_32x32x16_bf16(a, qb[kk], acc, 0, 0, 0); }
#pragma unroll
            for (int r = 0; r < 16; ++r) acc[r] *= rinv;
            if (t >= 4) {
                const int pp = (t == 4) ? (pos >> 6) : (pos & 63);
#pragma unroll
                for (int r = 0; r < 8; ++r) { const float2 cs = *(const float2*)(rope + (pp * 16 + 8 * hi + r) * 2);
                    const float x1 = acc[r], x2 = acc[r + 8]; acc[r] = x1 * cs.x - x2 * cs.y; acc[r + 8] = x2 * cs.x + x1 * cs.y; }
            }
            qr[2 * t] = pack8r(acc, 0); qr[2 * t + 1] = pack8r(acc, 8);
        }
    }
    LAS unsigned char* V_lds = lds + V_OFF; LAS unsigned char* K_lds = lds + K_OFF;
    const LAS unsigned char* Kl0 = K_lds + r32 * KROW + hi * 16; const LAS unsigned char* Kl1 = Kl0 + SHM_K;
    const int sr = tid >> 4, sc = (tid & 15) * 8, sr2 = tid >> 3, sc2 = 128 + (tid & 7) * 8;
    const unsigned goA = (unsigned)(sr * QKD + sc) * 2u, goB = (unsigned)(sr2 * QKD + sc2) * 2u;
    const int vst0 = v_st(sr, sc), kst0 = sr * KROW + sc * 2, kst2 = sr2 * KROW + sc2 * 2;
    const int vb0 = (int)(unsigned)(uintptr_t)V_lds + v_rd_base(lane);
    struct { bf16x8 a0, a1, b0; } st_[2];
#define SLOAD(i, k0) do { const char* tb_ = (const char*)Kb + (size_t)(k0) * (QKD * 2); st_[i].a0 = *(const bf16x8*)(tb_ + goA); st_[i].a1 = *(const bf16x8*)(tb_ + 32 * QKD * 2 + goA); \
        st_[i].b0 = *(const bf16x8*)(tb_ + goB); } while (0)
#define SWRITE(b, i) do { *(LAS bf16x8*)(V_lds + (b) * SHM_V + vst0) = st_[i].a0; *(LAS bf16x8*)(V_lds + (b) * SHM_V + 8192 + vst0) = st_[i].a1; \
        *(LAS bf16x8*)(K_lds + (b) * SHM_K + kst0) = st_[i].a0; *(LAS bf16x8*)(K_lds + (b) * SHM_K + 32 * KROW + kst0) = st_[i].a1; *(LAS bf16x8*)(K_lds + (b) * SHM_K + kst2) = st_[i].b0; } while (0)
#define SWAIT() asm volatile("s_waitcnt vmcnt(3)" ::: "memory")
#define RESC(a) do { if (__any((a) < 1.f)) { _Pragma("unroll") for (int d = 0; d < 4; ++d) _Pragma("unroll") for (int r = 0; r < 16; ++r) o[d][r] *= (a); } } while (0)
    float m_reg = -1e30f, l_reg = 0.f; f32x16 o[4] = {};
    f32x16 pA0, pA1, pB0, pB1; float mnA, mnB, alA, alB; bf16x8 pa0, pa1, pa2, pa3;
    constexpr int SE = 0, SO = 1;
    SLOAD(SE, 0); asm volatile("s_waitcnt vmcnt(0)" ::: "memory"); SWRITE(0, SE); __syncthreads();
    qkt(pA0, pA1, Kl0, qr); partialSM(pA0, pA1, m_reg, mnA, alA);
    SLOAD(SO, KVBLK); SLOAD(SE, 2 * KVBLK);
    SWAIT(); SWRITE(1, SO); __syncthreads();
    for (int j = 1; j + 1 < NT; j += 2) {
        SBAR(); qkt(pB0, pB1, Kl1, qr);
        finishSM(pA0, pA1, alA, l_reg, pa0, pa1, pa2, pa3); SBAR();
        SLOAD(SO, (j + 2) * KVBLK); SBAR();
        pv_d0(o, vb0, pa0, pa1, pa2, pa3); partialSM(pB0, pB1, m_reg, mnB, alB);
        __syncthreads(); SWAIT(); SWRITE(0, SE);
        RESC(alB); __syncthreads();
        SBAR(); qkt(pA0, pA1, Kl0, qr);
        finishSM(pB0, pB1, alB, l_reg, pa0, pa1, pa2, pa3); SBAR();
        if (j + 3 < NT) SLOAD(SE, (j + 3) * KVBLK); SBAR();
        pv_d0(o, vb0 + SHM_V, pa0, pa1, pa2, pa3); partialSM(pA0, pA1, m_reg, mnA, alA);
        __syncthreads(); SWAIT(); SWRITE(1, SO);
        RESC(alA); __syncthreads();
    }
    SBAR(); qkt(pB0, pB1, Kl1, qr);
    finishSM(pA0, pA1, alA, l_reg, pa0, pa1, pa2, pa3); SBAR();
    pv_d0(o, vb0, pa0, pa1, pa2, pa3); partialSM(pB0, pB1, m_reg, mnB, alB);
    __syncthreads(); RESC(alB);
    finishSM(pB0, pB1, alB, l_reg, pa0, pa1, pa2, pa3); SBAR();
    pv_d0(o, vb0 + SHM_V, pa0, pa1, pa2, pa3);
#undef SLOAD
#undef SWRITE
#undef SWAIT
#undef RESC
    const float rl = __builtin_amdgcn_rcpf(l_reg);
    bf16x8 ob[8];
#pragma unroll
    for (int d = 0; d < 4; ++d) {
#pragma unroll
        for (int r = 0; r < 16; ++r) o[d][r] *= rl;
        ob[2 * d] = pack8r(o[d], 0); ob[2 * d + 1] = pack8r(o[d], 8); }
    bf16_t* arow = A2u + (size_t)(wid * 32 + r32) * 2048 + 4 * hi;
#pragma unroll
    for (int vt = 0; vt < 4; ++vt) {
        f32x16 at = {};
        const bf16_t* wrow = WvbPh + (size_t)(vt * 32 + r32) * KVL + hi * 8;
#pragma unroll
        for (int ks = 0; ks < 8; ++ks) { const bf16x8 a = *(const bf16x8*)(wrow + ks * 16); at = __builtin_amdgcn_mfma_f32_32x32x16_bf16(a, ob[ks], at, 0, 0, 0); }
#pragma unroll
        for (int g = 0; g < 4; ++g) { u32x2* pp = (u32x2*)(arow + vt * 32 + 8 * g); const u32x2 w = *pp;
            u32x2 ow; ow.x = cvt_pk_bf16(at[4 * g] * bflo(w.x), at[4 * g + 1] * bfhi(w.x)); ow.y = cvt_pk_bf16(at[4 * g + 2] * bflo(w.y), at[4 * g + 3] * bfhi(w.y)); *pp = ow; }
    }
}
#undef SBAR
}

__device__ __forceinline__ void p5_attn(const Params& P, LAS unsigned char* lds, const int wid) {
    const int lane = lane_id(), G = gridDim.x, c = blockIdx.x;
    const bf16_t* QA = (const bf16_t*)(P.ws + WS_QA); const bf16_t* WqT = (const bf16_t*)(P.ws + WS_WQT); const bf16_t* KC = (const bf16_t*)(P.ws + WS_KC);
    const bf16_t* WvbP = (const bf16_t*)(P.ws + WS_WVBT); const float* rope = (const float*)(P.ws + WS_ROPE); bf16_t* A2 = (bf16_t*)(P.ws + WS_SGM);
    constexpr int NU = NB * NH * (S / 256);
    for (int i = 0; ; ++i) {
        const int L = i * G + c; if (L >= NU) break;
        int b, h, qt;
        if (G == 256) { const int x = c & 7, loc = (i & 3) * 32 + (c >> 3); b = 2 * x + (i >> 2); h = loc >> 3; qt = loc & 7; }
        else { b = L / (NH * 8); h = (L >> 3) % NH; qt = L & 7; }
        const int tok0 = b * S + qt * 256;
        att::attn_unit(QA + (size_t)tok0 * QL, WqT + (size_t)h * QKD * QL, KC + (size_t)b * NKEY * QKD, WvbP + (size_t)h * VD * KVL, rope,
                       A2 + (size_t)tok0 * 2048 + h * VD, qt * 256, lds, wid, lane);
    }
}

__device__ __forceinline__ void p8_final(const Params& P, const int wave) {
    const int lane = lane_id(), gw = blockIdx.x * NWAVES + wave, NGW = gridDim.x * NWAVES;
    for (int row = gw; row < M; row += NGW) {
        float* p = P.out + (size_t)row * D; f32x4 v[4]; float ss = 0.f;
#pragma unroll
        for (int j = 0; j < 4; ++j) { v[j] = *(const f32x4*)(p + 256 * j + 4 * lane); ss += v[j][0] * v[j][0] + v[j][1] * v[j][1] + v[j][2] * v[j][2] + v[j][3] * v[j][3]; }
        const float rinv = rsqrtf(wave_sum(ss) * (1.f / D) + EPS);
#pragma unroll
        for (int j = 0; j < 4; ++j) { const f32x4 g = *(const f32x4*)(P.final_g + 256 * j + 4 * lane); *(f32x4*)(p + 256 * j + 4 * lane) = v[j] * rinv * g; }
    }
}

__global__ void __launch_bounds__(NTHREADS, 2) fwd_megakernel(Params P) {
    extern __shared__ __attribute__((aligned(16))) unsigned char lds[];
    cg::grid_group grid = cg::this_grid();
    LAS unsigned char* ldsl = (LAS unsigned char*)lds;
    unsigned char* ws = P.ws; const int G = gridDim.x, bid = blockIdx.x, wid = __builtin_amdgcn_readfirstlane(threadIdx.x >> 6);
    bf16_t* WINT = (bf16_t*)(ws + WS_WINT); bf16_t* WPOOL = (bf16_t*)(ws + WS_WPOOL); bf16_t* WPP = (bf16_t*)(ws + WS_WPP); bf16_t* WPM = (bf16_t*)(ws + WS_WPM); bf16_t* WOUT = (bf16_t*)(ws + WS_WOUT);
    bf16_t* U = (bf16_t*)(ws + WS_U); bf16_t* SGP = (bf16_t*)(ws + WS_SGP); bf16_t* SGM = (bf16_t*)(ws + WS_SGM); bf16_t* QA = (bf16_t*)(ws + WS_QA);
    bf16_t* GMP = (bf16_t*)(ws + WS_GMP); bf16_t* GMM = (bf16_t*)(ws + WS_GMM); float* KVA = (float*)(ws + WS_KVA);
    bf16_t* H = (bf16_t*)P.out; bf16_t* Dp = (bf16_t*)P.out; float* T = P.out; bf16_t* P1 = U; bf16_t* Z = SGP;

    volatile LAS unsigned* st = (volatile LAS unsigned*)(ldsl + 131072);
    if (threadIdx.x < 4) st[threadIdx.x] = 0u;
    __syncthreads();
    XcdBarrier xb; xb.bar = (unsigned*)(ws + WS_BAR); xb.x = xb_xcc_id(); xb.st = st;
    if (threadIdx.x == 0) (void)xb_add(&xb.bar[XB_XCNT(xb.x)], 1u);
#define GRID_BAR() xcd_barrier(xb, wid)
    p0_prep(P, lds, wid);
    asm volatile("s_waitcnt vmcnt(0)" ::: "memory"); __syncthreads();
    grid.sync();
    if (wid == 0 && lane_id() == 0) { __builtin_amdgcn_fence(__ATOMIC_ACQUIRE, "agent"); asm volatile("s_waitcnt vmcnt(0)" ::: "memory"); }
    __syncthreads();
    p1_h(P, wid);
    GRID_BAR();
    {
        pg8::Gemm g{H, WINT, 1024, 1024, 1024, 0}; pg8::StaticOrder so; so.init(M / 256, N1 / 256, G, bid, MC / 256);
        pg8::Epi1 e{U, SGP, QA, SGM, GMP, GMM, KVA, P.b_gate};
        pg8::gemm_phase(ldsl, g, so, e, wid);
    }
    GRID_BAR();
    p3_thin(P, wid);
    GRID_BAR();
    {
        pg8::Gemm g{Dp, WPOOL, 1024, 256, 256, 256}; pg8::StaticOrder so; so.init(M / 256, 4, G, bid, 0);
        pg8::Epi2 e{P.pool_scale, SGP, P1};
        pg8::gemm_phase(ldsl, g, so, e, wid);
    }
    GRID_BAR();
    p5_attn(P, ldsl, wid);
    GRID_BAR();
    {
        pg8::StaticOrder so; so.init(M / 256, 4, G, bid, 0);
        { pg8::Gemm g{P1, WPP, 1024, 1024, 1024, 0}; pg8::Epi3a e{GMP, T}; pg8::gemm_phase(ldsl, g, so, e, wid); }
        { pg8::Gemm g{SGM, WPM, 2048, 2048, 2048, 0}; pg8::Epi3b e{GMM, T, Z}; pg8::gemm_phase(ldsl, g, so, e, wid); }
    }
    GRID_BAR();
    {
        pg8::Gemm g{Z, WOUT, 1024, 1024, 1024, 0}; pg8::StaticOrder so; so.init(M / 256, 4, G, bid, 0);
        pg8::Epi4 e{P.x, (const float*)(ws + WS_ADA), P.out};
        pg8::gemm_phase(ldsl, g, so, e, wid);
    }
    GRID_BAR();
    p8_final(P, wid);
}

extern "C" void kernel_launch(void* const* d_in, const int* in_sizes, int n_in, void* d_out, int out_size, void* d_ws, size_t ws_size, hipStream_t stream) {
    static int grid_blocks = 0;
    if (grid_blocks == 0) {
        if (n_in != 19 || out_size != M * D || ws_size < WS_END) { fprintf(stderr, "kernel_launch: unexpected shapes (n_in %d out %d ws %zu need %zu)\n", n_in, out_size, ws_size, (size_t)WS_END); grid_blocks = -1; return; }
        int dev = 0, cus = 0, per_cu = 0;
        (void)hipGetDevice(&dev); (void)hipDeviceGetAttribute(&cus, hipDeviceAttributeMultiprocessorCount, dev);
        if (hipFuncSetAttribute((const void*)fwd_megakernel, hipFuncAttributeMaxDynamicSharedMemorySize, LDS_BYTES) != hipSuccess) { fprintf(stderr, "kernel_launch: hipFuncSetAttribute failed\n"); grid_blocks = -1; return; }
        if (hipOccupancyMaxActiveBlocksPerMultiprocessor(&per_cu, (const void*)fwd_megakernel, NTHREADS, LDS_BYTES) != hipSuccess || per_cu < 1) { fprintf(stderr, "kernel_launch: occupancy query failed (%d)\n", per_cu); grid_blocks = -1; return; }
        grid_blocks = cus * 1;
        fprintf(stderr, "kernel_launch: cus %d per_cu %d grid %d\n", cus, per_cu, grid_blocks);
    }
    if (grid_blocks < 0) return;
    Params p{};
    const float** pf = (const float**)&p;
    for (int i = 0; i < 19; ++i) pf[i] = (const float*)d_in[i];
    p.out = (float*)d_out; p.ws = (unsigned char*)d_ws;
    if (hipMemsetAsync((char*)d_ws + WS_BAR, 0, BAR_BYTES, stream) != hipSuccess) { fprintf(stderr, "kernel_launch: memset failed\n"); return; }
    void* args[] = {&p};
    hipError_t e = hipLaunchCooperativeKernel((const void*)fwd_megakernel, dim3(grid_blocks), dim3(NTHREADS), args, LDS_BYTES, stream);
    if (e != hipSuccess) fprintf(stderr, "kernel_launch: cooperative launch failed: %s (grid %d)\n", hipGetErrorString(e), grid_blocks);
}
```

```cpp
#include <hip/hip_runtime.h>
#include <hip/hip_cooperative_groups.h>
#include <cstdint>
#include <cstdio>
namespace cg = cooperative_groups;

#ifndef PROBE_ATTN
#define PROBE_ATTN 0
#endif
#define AT_BEGIN(k) unsigned long long at0_ = 0; if (PROBE_ATTN == (k)) at0_ = __builtin_amdgcn_s_memrealtime();
#define AT_END(k) if (PROBE_ATTN == (k)) { const unsigned long long t1_ = __builtin_amdgcn_s_memrealtime(); while (__builtin_amdgcn_s_memrealtime() - t1_ < t1_ - at0_) __builtin_amdgcn_s_sleep(8); }
typedef unsigned short bf16_t;
typedef short bf16x8 __attribute__((ext_vector_type(8)));
typedef float f32x4 __attribute__((ext_vector_type(4)));
typedef unsigned u32x4 __attribute__((ext_vector_type(4)));
typedef unsigned u32x2 __attribute__((ext_vector_type(2)));
#define LAS __attribute__((address_space(3)))

constexpr int D = 1024, NB = 16, S = 2048, CTX = 256, M = NB * S, MC = NB * CTX, MT = M + MC, NKEY = S + CTX;
constexpr int NH = 16, QKN = 128, QKR = 64, VD = 128, QL = 256, KVL = 128, QKD = QKN + QKR;
constexpr int INW = 6592, N1 = 6656;
constexpr int C_U = 0, C_GP = 1024, C_QA = 2048, C_GM = 2304, C_MP = 4352, C_MM = 5376, C_KV = 6400;
constexpr float EPS = 1e-6f;
constexpr int NTHREADS = 512, NWAVES = 8;
constexpr int LDS_BYTES = 147456;

constexpr size_t al256(size_t x) { return (x + 255) / 256 * 256; }
constexpr size_t WS_ADA   = 0;
constexpr size_t WS_ROPE  = WS_ADA   + al256((size_t)17 * 3072 * 4);
constexpr size_t WS_WINT  = WS_ROPE  + al256((size_t)64 * 16 * 2 * 4);
constexpr size_t WS_WCAT  = WS_WINT  + al256((size_t)N1 * D * 2);
constexpr size_t WS_WOUT  = WS_WCAT  + al256((size_t)1024 * 3072 * 2);
constexpr size_t WS_WQT   = WS_WOUT  + al256((size_t)1024 * 1024 * 2);
constexpr size_t WS_WVBT  = WS_WQT   + al256((size_t)NH * QKD * QL * 2);
constexpr size_t WS_U     = WS_WVBT  + al256((size_t)NH * VD * KVL * 2);
constexpr size_t WS_SGP   = WS_U     + al256((size_t)M * 1024 * 2);
constexpr size_t WS_CAT   = WS_SGP   + al256((size_t)M * 1024 * 2);
constexpr size_t WS_QA    = WS_CAT   + al256((size_t)M * 3072 * 2);
constexpr size_t WS_GMP   = WS_QA    + al256((size_t)M * 256 * 2);
constexpr size_t WS_GMM   = WS_GMP   + al256((size_t)M * 1024 * 2);
constexpr size_t WS_KC    = WS_GMM   + al256((size_t)M * 1024 * 2);
constexpr size_t WS_BAR   = WS_KC    + al256((size_t)NB * NKEY * QKD * 2);
constexpr size_t OUT_KVA  = (size_t)80 << 20;
constexpr size_t BAR_BYTES = 16384;
constexpr int ADA_CNT_WORD = 3584;
constexpr size_t WS_END   = WS_BAR   + BAR_BYTES;

struct Params {
    const float *x, *c, *ctx, *c_ctx, *ada_w, *ada_b, *norm_g, *w_in, *b_gate, *w_pool, *pool_scale, *q_norm_g, *w_qb, *kv_norm_g, *w_kvb, *w_pp, *w_pm, *w_out, *final_g;
    float* out; unsigned char* ws;
};

__device__ __forceinline__ bf16_t f2bf(float f) { unsigned u = __float_as_uint(f); u += 0x7fffu + ((u >> 16) & 1u); return (bf16_t)(u >> 16); }
__device__ __forceinline__ float bf2f(bf16_t b) { return __uint_as_float(((unsigned)b) << 16); }
__device__ __forceinline__ float bflo(unsigned w) { return __uint_as_float(w << 16); }
__device__ __forceinline__ float bfhi(unsigned w) { return __uint_as_float(w & 0xffff0000u); }
__device__ __forceinline__ unsigned cvt_pk_bf16(float lo, float hi) { unsigned r; asm volatile("s_nop 0\n\tv_cvt_pk_bf16_f32 %0, %1, %2" : "=v"(r) : "v"(lo), "v"(hi)); return r; }
__device__ __forceinline__ float siluf(float v) { return v / (1.f + __expf(-v)); }
__device__ __forceinline__ float sigmf(float v) { return 1.f / (1.f + __expf(-v)); }
__device__ __forceinline__ int lane_id() { unsigned z = 0u; asm volatile("" : "+v"(z)); return (int)__builtin_amdgcn_mbcnt_hi(~0u, __builtin_amdgcn_mbcnt_lo(~0u, z)); }
template <int K> __device__ __forceinline__ float swz_xor(float v) { return __uint_as_float((unsigned)__builtin_amdgcn_ds_swizzle((int)__float_as_uint(v), (K << 10) | 0x1f)); }
__device__ __forceinline__ float half_swap_sum(float v) { auto rr = __builtin_amdgcn_permlane32_swap(__float_as_uint(v), __float_as_uint(v), false, false); return __uint_as_float(rr[0]) + __uint_as_float(rr[1]); }
__device__ __forceinline__ float half_swap_max(float v) { auto rr = __builtin_amdgcn_permlane32_swap(__float_as_uint(v), __float_as_uint(v), false, false); return fmaxf(__uint_as_float(rr[0]), __uint_as_float(rr[1])); }
__device__ __forceinline__ float wave_sum(float v) {
    v += swz_xor<1>(v); v += swz_xor<2>(v); v += swz_xor<4>(v); v += swz_xor<8>(v); v += swz_xor<16>(v);
    return half_swap_sum(v);
}
__device__ __forceinline__ float wave_max(float v) {
    v = fmaxf(v, swz_xor<1>(v)); v = fmaxf(v, swz_xor<2>(v)); v = fmaxf(v, swz_xor<4>(v)); v = fmaxf(v, swz_xor<8>(v)); v = fmaxf(v, swz_xor<16>(v));
    return half_swap_max(v);
}

#define XB_TMO      128
#define XB_XCNT(j)  (256  + 64 * (j))
#define XB_XSUB(j)  (1280 + 64 * (j))
#define XB_XGEN(j)  (2304 + 64 * (j))
#define XB_TOP      3328
#define XB_TOPGEN   3392
#define XB_SPIN_CAP (1u << 24)
__device__ __forceinline__ unsigned xb_ld(unsigned* p)              { return __hip_atomic_load(p, __ATOMIC_RELAXED, __HIP_MEMORY_SCOPE_AGENT); }
__device__ __forceinline__ unsigned xb_add(unsigned* p, unsigned v) { return __hip_atomic_fetch_add(p, v, __ATOMIC_RELAXED, __HIP_MEMORY_SCOPE_AGENT); }
__device__ __forceinline__ unsigned xb_xcc_id() { return (unsigned)__builtin_amdgcn_s_getreg((3 << 11) | 20) & 0xFu; }
#define XB_SPIN(cond, bar) do { unsigned _sp = 0; while (cond) { __builtin_amdgcn_s_sleep(1); \
    if ((++_sp & 255u) == 0u) { if (xb_ld(&(bar)[XB_TMO])) break; if (_sp > XB_SPIN_CAP) { atomicAdd(&(bar)[XB_TMO], 1u); break; } } } } while (0)
struct XcdBarrier { unsigned* bar; unsigned x; volatile LAS unsigned* st; };
__device__ __forceinline__ void xcd_barrier_complete(unsigned* bar, unsigned x, unsigned& nloc, unsigned& nx) {
    const unsigned G = gridDim.x * gridDim.y * gridDim.z;
    unsigned sum, cnt, mine, sp = 0u;
    for (;;) {
        sum = 0u; cnt = 0u; mine = 0u;
#pragma unroll
        for (unsigned j = 0; j < 16; ++j) { const unsigned c = xb_ld(&bar[XB_XCNT(j)]); sum += c; cnt += (c > 0u) ? 1u : 0u; mine = (j == x) ? c : mine; }
        if (sum == G) break;
        __builtin_amdgcn_s_sleep(1);
        if ((++sp & 255u) == 0u) { if (xb_ld(&bar[XB_TMO])) break; if (sp > XB_SPIN_CAP) { atomicAdd(&bar[XB_TMO], 1u); break; } }
    }
    nloc = mine > 0u ? mine : 1u; nx = cnt > 0u ? cnt : 1u;
}
__device__ __forceinline__ void xcd_barrier(const XcdBarrier& b, const int wid) {
    const bool leader = (wid == 0) && (lane_id() == 0);
    asm volatile("s_waitcnt vmcnt(0)" ::: "memory");
    __syncthreads();
    if (leader) {
        unsigned* bar = b.bar;
        __builtin_amdgcn_s_waitcnt(0);
        unsigned nloc = b.st[0], nx = b.st[1];
        if (nloc == 0u) { xcd_barrier_complete(bar, b.x, nloc, nx); b.st[0] = nloc; b.st[1] = nx; }
        const unsigned old = xb_add(&bar[XB_XSUB(b.x)], 1u);
        const unsigned gen = old / nloc;
        if (old + 1u == (gen + 1u) * nloc) {
            __builtin_amdgcn_fence(__ATOMIC_RELEASE, "agent");
            asm volatile("s_waitcnt vmcnt(0)" ::: "memory");
            const unsigned og = xb_add(&bar[XB_TOP], 1u);
            const unsigned tg = og / nx;
            if (og + 1u == (tg + 1u) * nx) xb_add(&bar[XB_TOPGEN], 1u);
            else XB_SPIN(xb_ld(&bar[XB_TOPGEN]) == tg, bar);
            __builtin_amdgcn_fence(__ATOMIC_ACQUIRE, "agent");
            xb_add(&bar[XB_XGEN(b.x)], 1u);
            asm volatile("s_waitcnt vmcnt(0)" ::: "memory");
        } else {
            XB_SPIN(xb_ld(&bar[XB_XGEN(b.x)]) == gen, bar);
            __builtin_amdgcn_fence(__ATOMIC_ACQUIRE, "agent");
            asm volatile("s_waitcnt vmcnt(0)" ::: "memory");
        }
    }
    __syncthreads();
}

namespace pg8 {
constexpr int BM = 256, BK = 64, HALF = 128, HTB = HALF * BK * 2  , NXCD = 8, WGM = 8;
__host__ __device__ __forceinline__ int lds_byte(int r, int c) { const int st = (r >> 4) * 2 + (c >> 5), rr = r & 15, cc = c & 31, ob = rr * 64 + cc * 2; return st * 1024 + (ob ^ (((ob >> 9) & 1) << 5)); }
__host__ __device__ __forceinline__ void stage_rc(int b, int& R, int& C) { const int st = b / 1024, sb = b % 1024, swz = sb ^ (((sb >> 9) & 1) << 5); R = (st >> 1) * 16 + swz / 64; C = (st & 1) * 32 + (swz % 64) / 2; }
__host__ __device__ __forceinline__ int perm32(int rho) { const int n = rho >> 4, i = rho & 15; return 8 * (i >> 2) + 4 * n + (i & 3); }

struct Unit { int pm, pn; };
struct Gemm { const bf16_t* A; const bf16_t* Bt; int lda, ldb, K, a_koff_pn; };

struct StaticOrder {
    int nM, nN, nwg, G, c, extra;
    __device__ void init(int nM_, int nN_, int G_, int c_, int extra_) { nM = nM_; nN = nN_; nwg = nM * nN; G = G_; c = c_; extra = extra_; }
    __device__ bool next(int i, Unit& u) const {
        const long L = (long)i * G + c; if (L >= nwg + extra) return false;
        if (L >= nwg) { u.pm = nM + (int)(L - nwg); u.pn = nN - 1; return true; }
        int wgid = (int)L; { const int q = nwg / NXCD, r = nwg % NXCD, xcd = wgid % NXCD, off = wgid / NXCD; wgid = (xcd < r ? xcd * (q + 1) : r * (q + 1) + (xcd - r) * q) + off; }
        const int nig = WGM * nN, gid = wgid / nig, fm = gid * WGM, gsz = (nM - fm) < WGM ? (nM - fm) : WGM;
        u.pm = fm + ((wgid % nig) % gsz); u.pn = (wgid % nig) / gsz; return true;
    }
};

typedef f32x4 Acc[2][2][4][2];

struct NoHook { static constexpr int T = -1; __device__ __forceinline__ void operator()(Acc&, const Unit&, int, int, int, int) const {} };
struct OneUnit { Unit u; __device__ bool next(int i, Unit& o) const { if (i != 0) return false; o = u; return true; } };
template <class Epi, class Hook = NoHook, class Sched = StaticOrder>
__device__ __forceinline__ void gemm_phase(LAS unsigned char* lds, const Gemm g, const Sched& S, const Epi& E, const int wid, const Hook& H = Hook()) {
    const int lane = lane_id(), tid = wid * 64 + lane, wr = wid >> 2, wc = wid & 3, fr = lane & 15, fq = lane >> 4;
    const int K = g.K, nt = K / BK;
    unsigned voffA[2], voffB[2];
#pragma unroll
    for (int i = 0; i < 2; ++i) { int R, C; stage_rc(tid * 16 + i * 8192, R, C); const int Rb = (R & ~31) + perm32(R & 31);
        voffA[i] = (unsigned)(R * g.lda + C) * 2u; voffB[i] = (unsigned)(Rb * g.ldb + C) * 2u; }
    const size_t kstep = (size_t)(BK * 2);
    const size_t hstepA = (size_t)HALF * g.lda * 2, hstepB = (size_t)HALF * g.ldb * 2;
    const size_t tstepA = 2 * hstepA, tstepB = 2 * hstepB;
    const unsigned ldsw = (unsigned)wid * 1024u;
    const int aoff = lds_byte(wr * 64 + fr, fq * 8), boff = lds_byte(wc * 32 + fr, fq * 8);
#define PG8_SA(b, h) (((b) * 2 + (h)) * HTB)
#define PG8_SB(b, h) ((4 + (b) * 2 + (h)) * HTB)
#define PG8_STAGE(bufoff, gbase, voff) do { _Pragma("unroll") for (int _i = 0; _i < 2; ++_i) \
        __builtin_amdgcn_global_load_lds((const unsigned*)((const char*)(gbase) + (voff)[_i]), (LAS unsigned*)(lds + (bufoff) + ldsw + _i * 8192), 16, 0, 0); } while (0)
#define PG8_LDA(dst, b, h) do { _Pragma("unroll") for (int m = 0; m < 4; ++m) _Pragma("unroll") for (int k = 0; k < 2; ++k) dst[m][k] = *(const LAS bf16x8*)(lds + PG8_SA(b, h) + aoff + m * 2048 + k * 1024); } while (0)
#define PG8_LDB(dst, b, h) do { _Pragma("unroll") for (int n = 0; n < 2; ++n) _Pragma("unroll") for (int k = 0; k < 2; ++k) dst[n][k] = *(const LAS bf16x8*)(lds + PG8_SB(b, h) + boff + n * 2048 + k * 1024); } while (0)
#define PG8_MMA(ai, bj, At, Bt) do { __builtin_amdgcn_s_setprio(1); _Pragma("unroll") for (int m = 0; m < 4; ++m) _Pragma("unroll") for (int n = 0; n < 2; ++n) _Pragma("unroll") for (int k = 0; k < 2; ++k) \
        acc[ai][bj][m][n] = __builtin_amdgcn_mfma_f32_16x16x32_bf16(Bt[n][k], At[m][k], acc[ai][bj][m][n], 0, 0, 0); __builtin_amdgcn_s_setprio(0); } while (0)
#define PG8_WAIT_V(n) asm volatile("s_waitcnt vmcnt(" #n ")" ::: "memory")
#define PG8_WAIT_L(n) asm volatile("s_waitcnt lgkmcnt(" #n ")" ::: "memory")
#define PG8_BAR __builtin_amdgcn_s_barrier()
#define PG8_SCHED __builtin_amdgcn_sched_barrier(0)
    Unit cur, nxt; int ui = 0;
    if (!S.next(0, cur)) return;
    Acc acc;
#pragma unroll
    for (int a = 0; a < 2; ++a)
#pragma unroll
        for (int b = 0; b < 2; ++b)
#pragma unroll
            for (int m = 0; m < 4; ++m)
#pragma unroll
                for (int n = 0; n < 2; ++n) acc[a][b][m][n] = (f32x4){0.f, 0.f, 0.f, 0.f};
    bf16x8 At[4][2], B0[2][2], B1[2][2];
    const char* cA = (const char*)g.A + (size_t)cur.pm * tstepA + (size_t)cur.pn * g.a_koff_pn * 2; const char* cB = (const char*)g.Bt + (size_t)cur.pn * tstepB;
    PG8_STAGE(PG8_SB(0, 0), cB, voffB); PG8_STAGE(PG8_SB(0, 1), cB + hstepB, voffB); PG8_STAGE(PG8_SA(0, 0), cA, voffA); PG8_STAGE(PG8_SA(0, 1), cA + hstepA, voffA);
    if (wr == 1) PG8_BAR;
    PG8_WAIT_V(2); PG8_BAR;
    PG8_STAGE(PG8_SB(1, 0), cB + kstep, voffB); PG8_STAGE(PG8_SA(1, 0), cA + kstep, voffA); PG8_STAGE(PG8_SB(1, 1), cB + hstepB + kstep, voffB);
    PG8_WAIT_V(6); PG8_BAR;
    for (;;) {
        const bool has_next = S.next(ui + 1, nxt);
        const char* nA = has_next ? (const char*)g.A + (size_t)nxt.pm * tstepA + (size_t)nxt.pn * g.a_koff_pn * 2 : cA; const char* nB = has_next ? (const char*)g.Bt + (size_t)nxt.pn * tstepB : cB;
        for (int t = 0; t < nt; t += 2) {
            const bool last = (t == nt - 2);
            const char* a1 = cA + (size_t)(t + 1) * kstep;
            const char* a2 = last ? nA : cA + (size_t)(t + 2) * kstep; const char* b2 = last ? nB : cB + (size_t)(t + 2) * kstep;
            const char* a3 = a2 + kstep; const char* b3 = b2 + kstep;
            if constexpr (Hook::T >= 0) { if (t == Hook::T) H(acc, cur, wr, wc, fr, fq); }
            PG8_LDB(B0, 0, 0); PG8_LDB(B1, 0, 1); PG8_SCHED; PG8_LDA(At, 0, 0); PG8_STAGE(PG8_SA(1, 1), a1 + hstepA, voffA);
            PG8_WAIT_V(8); PG8_WAIT_L(0); PG8_BAR; PG8_MMA(0, 0, At, B0); PG8_MMA(0, 1, At, B1); PG8_BAR; PG8_SCHED;
            PG8_LDA(At, 0, 1); PG8_STAGE(PG8_SB(0, 0), b2, voffB); PG8_STAGE(PG8_SB(0, 1), b2 + hstepB, voffB); PG8_STAGE(PG8_SA(0, 0), a2, voffA);
            PG8_WAIT_V(8); PG8_WAIT_L(0); PG8_BAR; PG8_MMA(1, 0, At, B0); PG8_MMA(1, 1, At, B1); PG8_BAR; PG8_SCHED;
            PG8_LDB(B0, 1, 0); PG8_LDB(B1, 1, 1); PG8_SCHED; PG8_LDA(At, 1, 0); PG8_STAGE(PG8_SA(0, 1), a2 + hstepA, voffA);
            PG8_WAIT_V(8); PG8_WAIT_L(0); PG8_BAR; PG8_MMA(0, 0, At, B0); PG8_MMA(0, 1, At, B1); PG8_BAR; PG8_SCHED;
            PG8_LDA(At, 1, 1); PG8_STAGE(PG8_SB(1, 0), b3, voffB); PG8_STAGE(PG8_SB(1, 1), b3 + hstepB, voffB); PG8_STAGE(PG8_SA(1, 0), a3, voffA);
            PG8_WAIT_V(8); PG8_WAIT_L(0); PG8_BAR; PG8_MMA(1, 0, At, B0); PG8_MMA(1, 1, At, B1); PG8_BAR; PG8_SCHED;
        }
        if (wr == 0) PG8_BAR;
        E(acc, cur, wr, wc, fr, fq);
        if (!has_next) break;
#pragma unroll
        for (int a = 0; a < 2; ++a)
#pragma unroll
            for (int b = 0; b < 2; ++b)
#pragma unroll
                for (int m = 0; m < 4; ++m)
#pragma unroll
                    for (int n = 0; n < 2; ++n) acc[a][b][m][n] = (f32x4){0.f, 0.f, 0.f, 0.f};
        cur = nxt; cA = nA; cB = nB; ++ui;
        if (wr == 1) PG8_BAR;
    }
    PG8_WAIT_V(0);
    PG8_BAR;
#undef PG8_SA
#undef PG8_SB
#undef PG8_STAGE
#undef PG8_LDA
#undef PG8_LDB
#undef PG8_MMA
#undef PG8_WAIT_V
#undef PG8_WAIT_L
#undef PG8_BAR
#undef PG8_SCHED
}

#define EPI_FOREACH(...) _Pragma("unroll") for (int ai = 0; ai < 2; ++ai) _Pragma("unroll") for (int m = 0; m < 4; ++m) { const int row = u.pm * BM + ai * HALF + wr * 64 + m * 16 + fr; \
        _Pragma("unroll") for (int bj = 0; bj < 2; ++bj) { const int ct = bj * HALF + wc * 32 + 8 * fq; const f32x4 v0 = acc[ai][bj][m][0], v1 = acc[ai][bj][m][1]; __VA_ARGS__ } }
__device__ __forceinline__ u32x4 pack8(const f32x4 a, const f32x4 b) { u32x4 w; w.x = cvt_pk_bf16(a[0], a[1]); w.y = cvt_pk_bf16(a[2], a[3]); w.z = cvt_pk_bf16(b[0], b[1]); w.w = cvt_pk_bf16(b[2], b[3]); return w; }
__device__ __forceinline__ void unpack8(const u32x4 w, f32x4& a, f32x4& b) { a = (f32x4){bflo(w.x), bfhi(w.x), bflo(w.y), bfhi(w.y)}; b = (f32x4){bflo(w.z), bfhi(w.z), bflo(w.w), bfhi(w.w)}; }
__device__ __forceinline__ f32x4 act4(f32x4 v, int mode) {
    f32x4 o;
#pragma unroll
    for (int j = 0; j < 4; ++j) { const float s = __builtin_amdgcn_rcpf(1.f + __expf(-v[j])); o[j] = mode == 1 ? v[j] * s : s; }
    return o;
}
struct Epi1 {
    bf16_t *UW, *SGP, *QA, *CAT, *GMP, *GMM; float* KVA; const float* b_gate;
    __device__ __forceinline__ void operator()(const Acc& acc, const Unit& u, int wr, int wc, int fr, int fq) const {
        const int pn = u.pn;
        if (pn == 8) {
            EPI_FOREACH({ *(u32x4*)(QA + ((size_t)(row >> 5) * 8192 + (size_t)(ct >> 4) * 512 + (size_t)(row & 31) * 16 + (ct & 8))) = pack8(v0, v1); }) return; }
        if (pn == 25) { EPI_FOREACH({ float* p = KVA + (size_t)row * 256 + ct; *(f32x4*)p = v0; *(f32x4*)(p + 4) = v1; }) return; }
        bf16_t* base; int ld, c0, mode = 0; const float* bias = nullptr;
        if (pn < 4) { base = UW; ld = 1024; c0 = pn * 256; }
        else if (pn < 8) { base = SGP; ld = 1024; c0 = (pn - 4) * 256; mode = 1; }
        else if (pn < 9) { base = QA; ld = 256; c0 = 0; }
        else if (pn < 17) { base = CAT; ld = 3072; c0 = 1024 + (pn - 9) * 256; mode = 1; }
        else if (pn < 21) { base = GMP; ld = 1024; c0 = (pn - 17) * 256; mode = 2; bias = b_gate + c0; }
        else { base = GMM; ld = 1024; c0 = (pn - 21) * 256; mode = 2; bias = b_gate + 1024 + c0; }
        if (mode == 0) { EPI_FOREACH({ *(u32x4*)(base + (size_t)row * ld + c0 + ct) = pack8(v0, v1); }) }
        else if (mode == 1) { EPI_FOREACH({ *(u32x4*)(base + (size_t)row * ld + c0 + ct) = pack8(act4(v0, 1), act4(v1, 1)); }) }
        else { f32x4 bb[2][2];
#pragma unroll
               for (int bj = 0; bj < 2; ++bj) { const float* pb = bias + bj * HALF + wc * 32 + 8 * fq; bb[bj][0] = *(const f32x4*)pb; bb[bj][1] = *(const f32x4*)(pb + 4); }
               EPI_FOREACH({ *(u32x4*)(base + (size_t)row * ld + c0 + ct) = pack8(act4(v0 + bb[bj][0], 2), act4(v1 + bb[bj][1], 2)); }) }
    }
};
struct Hook3 {
    static constexpr int T = 16;
    const bf16_t *GMP, *GMM;
    __device__ __forceinline__ void operator()(Acc& acc, const Unit& u, int wr, int wc, int fr, int fq) const {
        unsigned off = ((unsigned)(u.pm * BM + wr * 64 + fr) * 1024u + (unsigned)(u.pn * 256 + wc * 32 + 8 * fq)) * 2u;
#pragma unroll
        for (int ai = 0; ai < 2; ++ai)
#pragma unroll
            for (int mp = 0; mp < 2; ++mp) {
                asm volatile("" : "+v"(off) :: "memory");
                u32x4 gp[2][2], gm[2][2];
#pragma unroll
                for (int mm = 0; mm < 2; ++mm)
#pragma unroll
                    for (int bj = 0; bj < 2; ++bj) { gp[mm][bj] = *(const u32x4*)((const char*)GMP + off + mm * 32768 + bj * 256); gm[mm][bj] = *(const u32x4*)((const char*)GMM + off + mm * 32768 + bj * 256); }
#pragma unroll
                for (int mm = 0; mm < 2; ++mm)
#pragma unroll
                    for (int bj = 0; bj < 2; ++bj) { const int m = mp * 2 + mm; f32x4 p0, p1, q0, q1; unpack8(gp[mm][bj], p0, p1); unpack8(gm[mm][bj], q0, q1);
#pragma unroll
                        for (int j = 0; j < 4; ++j) { acc[ai][bj][m][0][j] *= p0[j] * __builtin_amdgcn_rcpf(q0[j]); acc[ai][bj][m][1][j] *= p1[j] * __builtin_amdgcn_rcpf(q1[j]); } }
                off += (mp == 1 ? 96u : 32u) * 2048u;
            }
    }
};
struct Epi3 {
    const bf16_t* GMM; bf16_t* Z;
    __device__ __forceinline__ void operator()(const Acc& acc, const Unit& u, int wr, int wc, int fr, int fq) const {
        u32x4 gt[2][4][2];
#pragma unroll
        for (int ai = 0; ai < 2; ++ai)
#pragma unroll
            for (int m = 0; m < 4; ++m)
#pragma unroll
                for (int bj = 0; bj < 2; ++bj) gt[ai][m][bj] = *(const u32x4*)(GMM + (size_t)(u.pm * BM + ai * HALF + wr * 64 + m * 16 + fr) * 1024 + u.pn * 256 + bj * HALF + wc * 32 + 8 * fq);
        asm volatile("s_waitcnt vmcnt(0)" ::: "memory"); __builtin_amdgcn_sched_barrier(0);
#pragma unroll
        for (int ai = 0; ai < 2; ++ai)
#pragma unroll
            for (int m = 0; m < 4; ++m)
#pragma unroll
                for (int bj = 0; bj < 2; ++bj) { f32x4 g0, g1; unpack8(gt[ai][m][bj], g0, g1);
                    *(u32x4*)(Z + (size_t)(u.pm * BM + ai * HALF + wr * 64 + m * 16 + fr) * 1024 + u.pn * 256 + bj * HALF + wc * 32 + 8 * fq) = pack8(acc[ai][bj][m][0] * g0, acc[ai][bj][m][1] * g1); }
    }
};
struct Epi4 {
    const float* ada; bf16_t* GY;
    __device__ __forceinline__ void operator()(const Acc& acc, const Unit& u, int wr, int wc, int fr, int fq) const {
        const float* gate = ada + ((u.pm * BM) / S) * 3072 + 2048;
        f32x4 gg[2][2];
#pragma unroll
        for (int bj = 0; bj < 2; ++bj) { const float* pg = gate + u.pn * 256 + bj * HALF + wc * 32 + 8 * fq; gg[bj][0] = *(const f32x4*)pg; gg[bj][1] = *(const f32x4*)(pg + 4); }
        EPI_FOREACH({ const int col = u.pn * 256 + ct; const size_t o = (size_t)row * 1024 + col;
            *(u32x4*)(GY + o) = pack8(gg[bj][0] * v0, gg[bj][1] * v1); })
    }
};
}

__device__ __forceinline__ void tr_item(const float* __restrict__ W, int ld, int N32, bf16_t* __restrict__ dst, int dst_ld, int dst_koff, int mode, const float* __restrict__ kscale,
                                        int item, LAS float* scr, int lane) {
    const int nb = item % N32, kb = item / N32, k0 = 64 * kb, n0 = 32 * nb, nl = lane & 31;
    int n = n0 + nl, col;
    if (mode == 0) col = n;
    else if (mode == 1) { n += 1024; col = n < C_GM ? n : (n < C_KV ? n + 192 : (n < C_KV + 192 ? n - C_KV + 2304 : -1)); }
    else if (mode == 2) col = (n >> 7) * 256 + 128 + (n & 127);
    else col = (n / 64) * 192 + 128 + (n % 64);
    float tv[32];
#pragma unroll
    for (int i = 0; i < 32; ++i) { const int kk = 2 * i + (lane >> 5), k = k0 + kk;
        const int ks = (mode == 2) ? ((k & ~15) + 8 * ((k & 7) >> 2) + 4 * ((k >> 3) & 1) + (k & 3)) : k;
        tv[i] = col >= 0 ? W[(size_t)ks * ld + col] * (kscale ? kscale[k] : 1.f) : 0.f; }
#pragma unroll
    for (int i = 0; i < 32; ++i) scr[(2 * i + (lane >> 5)) * 33 + nl] = tv[i];
    asm volatile("s_waitcnt lgkmcnt(0)" ::: "memory");
    const int c = lane & 7;
#pragma unroll
    for (int j = 0; j < 4; ++j) { const int nn = (lane >> 3) + 8 * j; const LAS float* sp = scr + (8 * c) * 33 + nn;
        u32x4 o; o.x = cvt_pk_bf16(sp[0 * 33], sp[1 * 33]); o.y = cvt_pk_bf16(sp[2 * 33], sp[3 * 33]); o.z = cvt_pk_bf16(sp[4 * 33], sp[5 * 33]); o.w = cvt_pk_bf16(sp[6 * 33], sp[7 * 33]);
        int ng = n0 + nn; size_t drow;
        if (mode == 1) drow = 1024 + ng; else if (mode == 3) drow = (size_t)(ng / 64) * 192 + 128 + (ng % 64); else drow = ng;
        *(u32x4*)(dst + drow * dst_ld + dst_koff + k0 + 8 * c) = o; }
    asm volatile("s_waitcnt lgkmcnt(0)" ::: "memory");
}
__device__ __forceinline__ void p0_prep(const Params& P, unsigned char* lds, LAS unsigned char* ldsl, const int wave) {
    unsigned char* ws = P.ws; float* fl = (float*)lds;
    const int lane = lane_id(), tid = wave * 64 + lane, bid = blockIdx.x, G = gridDim.x;
    float* ADA = (float*)(ws + WS_ADA);
    if (bid < 96) {
        float* sl = fl;
        float* red = fl + 17 * 1024;
        {
            f32x4 cv[9];
#pragma unroll
            for (int q = 0; q < 9; ++q) { const int i4 = tid + NTHREADS * q; const int r = i4 >> 8, k = (i4 & 255) * 4;
                cv[q] = (i4 < 17 * 256) ? *(const f32x4*)(r < 16 ? P.c + r * D + k : P.c_ctx + k) : (f32x4){0.f, 0.f, 0.f, 0.f}; }
#pragma unroll
            for (int q = 0; q < 9; ++q) { const int i4 = tid + NTHREADS * q;
                if (i4 < 17 * 256) { f32x4 o; for (int e = 0; e < 4; ++e) o[e] = siluf(cv[q][e]); *(f32x4*)(sl + i4 * 4) = o; } }
        }
        __syncthreads();
        const int j = bid * 32 + (lane & 31), kb = wave * 128 + (lane >> 5);
        float acc[17];
#pragma unroll
        for (int r = 0; r < 17; ++r) acc[r] = 0.f;
#pragma unroll 8
        for (int i = 0; i < 64; ++i) { const int k = kb + 2 * i; const float w = P.ada_w[(size_t)k * 3072 + j];
#pragma unroll
            for (int r = 0; r < 17; ++r) acc[r] += sl[r * 1024 + k] * w; }
#pragma unroll
        for (int r = 0; r < 17; ++r) { acc[r] = half_swap_sum(acc[r]); if (lane < 32) red[(wave * 17 + r) * 32 + lane] = acc[r]; }
        __syncthreads();
        for (int i = tid; i < 17 * 32; i += NTHREADS) { const int r = i >> 5, jj = i & 31; float s = 0.f;
            for (int w = 0; w < 8; ++w) s += red[(w * 17 + r) * 32 + jj];
            ADA[r * 3072 + bid * 32 + jj] = s + P.ada_b[bid * 32 + jj]; }
        asm volatile("s_waitcnt vmcnt(0)" ::: "memory"); __syncthreads();
        if (tid == 0) { __builtin_amdgcn_fence(__ATOMIC_RELEASE, "agent"); asm volatile("s_waitcnt vmcnt(0)" ::: "memory");
            __hip_atomic_fetch_add((unsigned*)(ws + WS_BAR) + ADA_CNT_WORD, 1u, __ATOMIC_RELAXED, __HIP_MEMORY_SCOPE_AGENT); }
    } else if (bid < 96 + 64) {
        const int it = bid - 96, h = it >> 2, k0 = (it & 3) * 64;
        float* As = fl;
        float* Bs = fl + 64 * 129;
        {
            f32x4 av[4], bv[8];
#pragma unroll
            for (int q = 0; q < 4; ++q) { const int i4 = tid + NTHREADS * q, kk = i4 >> 5, j = (i4 & 31) * 4; av[q] = *(const f32x4*)(P.w_qb + (size_t)(k0 + kk) * 3072 + h * 192 + j); }
#pragma unroll
            for (int q = 0; q < 8; ++q) { const int i4 = tid + NTHREADS * q, l = i4 >> 5, j = (i4 & 31) * 4; bv[q] = *(const f32x4*)(P.w_kvb + (size_t)l * 4096 + h * 256 + j); }
#pragma unroll
            for (int q = 0; q < 4; ++q) { const int i4 = tid + NTHREADS * q, kk = i4 >> 5, j = (i4 & 31) * 4; for (int e = 0; e < 4; ++e) As[kk * 129 + j + e] = av[q][e]; }
#pragma unroll
            for (int q = 0; q < 8; ++q) { const int i4 = tid + NTHREADS * q, l = i4 >> 5, j = (i4 & 31) * 4; for (int e = 0; e < 4; ++e) Bs[l * 129 + j + e] = bv[q][e]; }
        }
        __syncthreads();
        const int kk = tid & 63, lb = tid >> 6; const float qg = P.q_norm_g[k0 + kk];
#pragma unroll 1
        for (int i = 0; i < 16; ++i) { const int l = lb + 8 * i; float a = 0.f;
#pragma unroll 8
            for (int j = 0; j < 128; ++j) a += As[kk * 129 + j] * Bs[l * 129 + j];
            ((bf16_t*)(ws + WS_WQT))[((size_t)h * 192 + l) * 256 + k0 + kk] = f2bf(a * qg); }
        __syncthreads();
    } else if (bid == 96 + 64) {
        float* rope = (float*)(ws + WS_ROPE);
        for (int i = tid; i < 64 * 16; i += NTHREADS) { const int pos = i >> 4, f = i & 15; const float a = (float)pos * powf(10000.f, -(float)f / 16.f); rope[i * 2] = cosf(a); rope[i * 2 + 1] = sinf(a); }
    }
    __syncthreads();
    {
        LAS float* scr = (LAS float*)(ldsl + wave * 8448);
        constexpr int I_WIN = ((N1 - 1024) / 32) * 16, I_PP = 32 * 16, I_PM = 32 * 32, I_OUT = 32 * 16, I_VB = 64 * 2, I_QR = 32 * 4;
        constexpr int NITEMS = I_WIN + I_PP + I_PM + I_OUT + I_VB + I_QR;
        for (int it = bid * NWAVES + wave; it < NITEMS; it += G * NWAVES) {
            int r = it;
            if (r < I_WIN) { tr_item(P.w_in, INW, (N1 - 1024) / 32, (bf16_t*)(ws + WS_WINT), 1024, 0, 1, nullptr, r, scr, lane); continue; } r -= I_WIN;
            if (r < I_PP) { tr_item(P.w_pp, 1024, 32, (bf16_t*)(ws + WS_WCAT), 3072, 0, 0, nullptr, r, scr, lane); continue; } r -= I_PP;
            if (r < I_PM) { tr_item(P.w_pm, 1024, 32, (bf16_t*)(ws + WS_WCAT), 3072, 1024, 0, nullptr, r, scr, lane); continue; } r -= I_PM;
            if (r < I_OUT) { tr_item(P.w_out, 1024, 32, (bf16_t*)(ws + WS_WOUT), 1024, 0, 0, nullptr, r, scr, lane); continue; } r -= I_OUT;
            if (r < I_VB) { tr_item(P.w_kvb, 4096, 64, (bf16_t*)(ws + WS_WVBT), 128, 0, 2, nullptr, r, scr, lane); continue; } r -= I_VB;
            tr_item(P.w_qb, 3072, 32, (bf16_t*)(ws + WS_WQT), 256, 0, 3, P.q_norm_g, r, scr, lane);
        }
        __syncthreads();
    }
    for (int it = (bid + G - 160 % G) % G; it < 256; it += G) {
        const int g = it >> 6, k0 = ((it >> 2) & 15) * 64, d0 = (it & 3) * 64;
        float* As = fl;
        float* Bs = fl + 64 * 257;
        {
            f32x4 av[8], bv[8];
#pragma unroll
            for (int q = 0; q < 8; ++q) { const int i4 = tid + NTHREADS * q, kk = i4 >> 6, c = (i4 & 63) * 4; av[q] = *(const f32x4*)(P.w_in + (size_t)(k0 + kk) * INW + g * 256 + c); }
#pragma unroll
            for (int q = 0; q < 8; ++q) { const int i4 = tid + NTHREADS * q, c = i4 >> 4, d = (i4 & 15) * 4; bv[q] = *(const f32x4*)(P.w_pool + ((size_t)g * 256 + c) * 256 + d0 + d); }
#pragma unroll
            for (int q = 0; q < 8; ++q) { const int i4 = tid + NTHREADS * q, kk = i4 >> 6, c = (i4 & 63) * 4; for (int e = 0; e < 4; ++e) As[kk * 257 + c + e] = av[q][e]; }
#pragma unroll
            for (int q = 0; q < 8; ++q) { const int i4 = tid + NTHREADS * q, c = i4 >> 4, d = (i4 & 15) * 4; *(f32x4*)(Bs + c * 64 + d) = bv[q]; }
        }
        __syncthreads();
        const int kk = tid & 63, db = tid >> 6;
        f32x4 a0 = {0.f, 0.f, 0.f, 0.f}, a1 = {0.f, 0.f, 0.f, 0.f};
#pragma unroll 8
        for (int c = 0; c < 256; ++c) { const float av = As[kk * 257 + c]; const f32x4 b0 = *(const f32x4*)(Bs + c * 64 + 8 * db), b1 = *(const f32x4*)(Bs + c * 64 + 8 * db + 4);
            a0 += b0 * av; a1 += b1 * av; }
#pragma unroll
        for (int i = 0; i < 4; ++i) { ((bf16_t*)(ws + WS_WINT))[((size_t)g * 256 + d0 + 8 * db + i) * 1024 + k0 + kk] = f2bf(a0[i]);
                                      ((bf16_t*)(ws + WS_WINT))[((size_t)g * 256 + d0 + 8 * db + 4 + i) * 1024 + k0 + kk] = f2bf(a1[i]); }
        __syncthreads();
    }
}

__device__ __forceinline__ void h_rows(const Params& P, const int lane, const int first, const int step, const int last  ) {
    const float* ADA = (const float*)(P.ws + WS_ADA); bf16_t* H = (bf16_t*)P.out;
    f32x4 g[4];
#pragma unroll
    for (int j = 0; j < 4; ++j) g[j] = *(const f32x4*)(P.norm_g + 256 * j + 4 * lane);
    for (int row0 = 4 * first; row0 < last; row0 += 4 * step) {
        f32x4 v[4][4], ma[4], mb[4]; float ss[4];
        const float* sh = ADA + (row0 < M ? row0 / S : 16) * 3072, *sc = sh + 1024;
#pragma unroll
        for (int u = 0; u < 4; ++u) { const int row = row0 + u; const float* src = row < M ? P.x + (size_t)row * D : P.ctx + (size_t)(row - M) * D; ss[u] = 0.f;
#pragma unroll
            for (int j = 0; j < 4; ++j) { v[u][j] = *(const f32x4*)(src + 256 * j + 4 * lane); ss[u] += v[u][j][0] * v[u][j][0] + v[u][j][1] * v[u][j][1] + v[u][j][2] * v[u][j][2] + v[u][j][3] * v[u][j][3]; } }
#pragma unroll
        for (int j = 0; j < 4; ++j) { const int c0 = 256 * j + 4 * lane; ma[j] = g[j] * (*(const f32x4*)(sc + c0) + 1.f); mb[j] = *(const f32x4*)(sh + c0); }
#pragma unroll
        for (int u = 0; u < 4; ++u) { const int row = row0 + u;
            const float rinv = rsqrtf(wave_sum(ss[u]) * (1.f / D) + EPS);
#pragma unroll
            for (int j = 0; j < 4; ++j) { const int c0 = 256 * j + 4 * lane;
                const f32x4 o = v[u][j] * rinv * ma[j] + mb[j]; u32x2 w; w.x = cvt_pk_bf16(o[0], o[1]); w.y = cvt_pk_bf16(o[2], o[3]);
                *(u32x2*)(H + (size_t)row * D + c0) = w; } }
    }
}
__device__ __forceinline__ void p1_h(const Params& P, const int wave) {
    const int lane = lane_id();
    {
        if (wave == 0) { unsigned* cnt = (unsigned*)(P.ws + WS_BAR) + ADA_CNT_WORD; unsigned sp = 0;
            while ((unsigned)__builtin_amdgcn_readfirstlane((int)__hip_atomic_load(cnt, __ATOMIC_RELAXED, __HIP_MEMORY_SCOPE_AGENT)) < 96u) { __builtin_amdgcn_s_sleep(2); if (++sp > (1u << 22)) break; }
            __builtin_amdgcn_fence(__ATOMIC_ACQUIRE, "agent"); asm volatile("s_waitcnt vmcnt(0)" ::: "memory"); }
        __syncthreads();
    }
    h_rows(P, lane, blockIdx.x * NWAVES + wave, gridDim.x * NWAVES, MT);
}

__device__ __forceinline__ f32x4 ld4bf(const bf16_t* p) { const u32x2 w = *(const u32x2*)p; return (f32x4){bflo(w.x), bfhi(w.x), bflo(w.y), bfhi(w.y)}; }
template <int HW>
__device__ __forceinline__ void pool_half(const char* UWc, const char* SGPc, char* CATc, unsigned uo  , unsigned co  , const int tl  , const f32x4 ps) {
    constexpr int NR = 16 + 2 * HW;
    asm volatile("" : "+v"(uo), "+v"(co));
    u32x2 ur[NR], sr[16];
#pragma unroll
    for (int r = 0; r < NR; ++r) { const int row = tl - HW + r; const bool ok = (unsigned)row < (unsigned)S; ur[r] = *(const u32x2*)(UWc + (uo + (unsigned)((ok ? r - HW : 0) * 2048))); if (!ok) ur[r] = (u32x2){0u, 0u}; }
#pragma unroll
    for (int k = 0; k < 16; ++k) sr[k] = *(const u32x2*)(SGPc + (uo + (unsigned)(k * 2048)));
    auto f4 = [](const u32x2 w) { return (f32x4){bflo(w.x), bfhi(w.x), bflo(w.y), bfhi(w.y)}; };
    f32x4 sum = {0.f, 0.f, 0.f, 0.f};
#pragma unroll
    for (int r = 0; r < 2 * HW; ++r) sum += f4(ur[r]);
#pragma unroll
    for (int k = 0; k < 16; ++k) {
        const int t = tl + k, lo = max(t - HW, 0), hi = min(t + HW, S);
        const f32x4 o = (sum * (1.f / (float)(hi - lo)) - f4(ur[k + HW])) * ps * f4(sr[k]);
        u32x2 w; w.x = cvt_pk_bf16(o[0], o[1]); w.y = cvt_pk_bf16(o[2], o[3]);
        *(u32x2*)(CATc + (co + (unsigned)(k * 6144))) = w;
        sum += f4(ur[k + 2 * HW]) - f4(ur[k]);
    }
}
template <class Epi>
__device__ __forceinline__ void p3_thin(const Params& P, const int wave, LAS unsigned char* ldsl, const bool split, const Epi& e1) {
    const int lane = lane_id(), bid = blockIdx.x, G = gridDim.x;
    const bool ctxwg = split && bid < MC / 256;
    const int nthin = split ? G - MC / 256 : G, gw = ((split ? bid - MC / 256 : bid) * NWAVES + wave), NGW = nthin * NWAVES;
    const float* KVA = (const float*)((const unsigned char*)P.out + OUT_KVA); const float* rope = (const float*)(P.ws + WS_ROPE); bf16_t* KC = (bf16_t*)(P.ws + WS_KC);
    if (ctxwg) {
        {
            const int tid_ = wave * 64 + lane;
            const char* pa = (const char*)P.out + (size_t)(M + bid * 256) * 2048; const char* pb = (const char*)(P.ws + WS_WINT) + (size_t)C_KV * 2048;
#pragma unroll 1
            for (int i = 0; i < 8; ++i) {
                f32x4 t[16];
#pragma unroll
                for (int q = 0; q < 8; ++q) { t[q] = *(const f32x4*)(pa + (size_t)(i * 8 + q) * 8192 + tid_ * 16); t[8 + q] = *(const f32x4*)(pb + (size_t)(i * 8 + q) * 8192 + tid_ * 16); }
#pragma unroll
                for (int q = 0; q < 16; ++q) asm volatile("" :: "v"(t[q]));
            }
        }
        pg8::Gemm g{(const bf16_t*)P.out, (const bf16_t*)(P.ws + WS_WINT), 1024, 1024, 1024, 0};
        pg8::OneUnit ou{{M / 256 + bid, N1 / 256 - 1}};
        pg8::gemm_phase(ldsl, g, ou, e1, wave);
        asm volatile("s_waitcnt vmcnt(0)" ::: "memory"); __syncthreads();
        __builtin_amdgcn_fence(__ATOMIC_ACQUIRE, "agent"); asm volatile("s_waitcnt vmcnt(0)" ::: "memory"); __syncthreads();
    }
    const int l16 = lane & 15;
    const f32x4 g0 = *(const f32x4*)(P.kv_norm_g + 8 * l16), g1 = *(const f32x4*)(P.kv_norm_g + 8 * l16 + 4);
    const int kp_first = ctxwg ? (M + bid * 256) / 4 + wave : (split ? (gw < 0 ? 0 : gw) : gw), kp_step = ctxwg ? NWAVES : NGW, kp_last = ctxwg ? (M + bid * 256 + 256) / 4 : (split ? M / 4 : MT / 4);
    for (int it = kp_first; it < kp_last; it += kp_step) {
        const int t = it * 4 + (lane >> 4); const bool isx = t < M;
        const int b = isx ? t / S : (t - M) / CTX, pos = isx ? t % S : (t - M) % CTX, key = isx ? pos : S + pos;
        const float* src = KVA + (size_t)t * 256;
        const f32x4 c0 = *(const f32x4*)(src + 8 * l16), c1 = *(const f32x4*)(src + 8 * l16 + 4); f32x4 kr = *(const f32x4*)(src + 128 + 4 * l16);
        const int w8 = l16 & 7, pp = (l16 >= 8) ? (pos & 63) : (pos >> 6), i0 = 4 * (w8 & 3);
        f32x4 t0 = {0.f, 0.f, 0.f, 0.f}, t1 = t0;
        if (isx) { t0 = *(const f32x4*)(rope + (pp * 16 + i0) * 2); t1 = *(const f32x4*)(rope + (pp * 16 + i0) * 2 + 4); }
        float ss = c0[0] * c0[0] + c0[1] * c0[1] + c0[2] * c0[2] + c0[3] * c0[3] + c1[0] * c1[0] + c1[1] * c1[1] + c1[2] * c1[2] + c1[3] * c1[3];
        ss += swz_xor<1>(ss); ss += swz_xor<2>(ss); ss += swz_xor<4>(ss); ss += swz_xor<8>(ss);
        const float rinv = rsqrtf(ss * (1.f / KVL) + EPS);
        bf16_t* dst = KC + ((size_t)b * NKEY + key) * QKD;
        *(u32x4*)(dst + 8 * l16) = pg8::pack8(c0 * rinv * g0, c1 * rinv * g1);
        const f32x4 other = {swz_xor<4>(kr[0]), swz_xor<4>(kr[1]), swz_xor<4>(kr[2]), swz_xor<4>(kr[3])};
        if (isx) {
            const f32x4 cs = {t0[0], t0[2], t1[0], t1[2]}, sn = {t0[1], t0[3], t1[1], t1[3]};
            kr = (w8 < 4) ? kr * cs - other * sn : kr * cs + other * sn;
        }
        u32x2 o; o.x = cvt_pk_bf16(kr[0], kr[1]); o.y = cvt_pk_bf16(kr[2], kr[3]);
        *(u32x2*)(dst + 128 + 4 * l16) = o;
    }
    const bf16_t* UW = (const bf16_t*)(P.ws + WS_U); const bf16_t* SGP = (const bf16_t*)(P.ws + WS_SGP); bf16_t* CAT = (bf16_t*)(P.ws + WS_CAT);
    for (int it = ctxwg ? NB * 64 * 4 : gw; it < NB * 64 * 4; it += NGW) {
        const int g = it & 3, ch = (it >> 2) & 63, b = it >> 8, t0 = ch * 32, col = g * 256 + 4 * lane;
        const f32x4 ps = *(const f32x4*)(P.pool_scale + col);
#pragma unroll 1
        for (int th = t0; th < t0 + 32; th += 16) {
            const unsigned uo = (unsigned)(((b * S + th) * 1024 + col) * 2), co = (unsigned)(((size_t)(b * S + th) * 3072 + col) * 2);
            if (g == 0) pool_half<1>((const char*)UW, (const char*)SGP, (char*)CAT, uo, co, th, ps); else if (g == 1) pool_half<2>((const char*)UW, (const char*)SGP, (char*)CAT, uo, co, th, ps);
            else if (g == 2) pool_half<4>((const char*)UW, (const char*)SGP, (char*)CAT, uo, co, th, ps); else pool_half<8>((const char*)UW, (const char*)SGP, (char*)CAT, uo, co, th, ps);
        }
    }
}

namespace att {
using f32x16 = __attribute__((ext_vector_type(16))) float;
using s16x4  = __attribute__((ext_vector_type(4))) short;
constexpr float SCALE = 0.07216878364870322f;
constexpr float THR = 8.f;
constexpr int KVBLK = 64, NT = NKEY / KVBLK;
constexpr int WPITCH = 528, VPITCH = 272;
constexpr int KROW = 384;
constexpr int SHM_V = KVBLK * 128 * 2, SHM_K = KVBLK * KROW, V_OFF = 0, K_OFF = 3 * SHM_V;
static_assert(NT % 2 == 0 && K_OFF + 2 * SHM_K <= 131072 && 192 * WPITCH <= 131072, "attention LDS map");
#define SBAR() __builtin_amdgcn_sched_barrier(0)
__device__ __forceinline__ int crow(int r, int hi) { return (r & 3) + 8 * (r >> 2) + 4 * hi; }
__device__ __forceinline__ bf16x8 pack8r(const f32x16& a, int base) {
    u32x4 w = {cvt_pk_bf16(a[base + 0], a[base + 1]), cvt_pk_bf16(a[base + 2], a[base + 3]), cvt_pk_bf16(a[base + 4], a[base + 5]), cvt_pk_bf16(a[base + 6], a[base + 7])};
    return *reinterpret_cast<bf16x8*>(&w);
}
constexpr float CL2 = SCALE * 1.4426950408889634f;
#define PK4(P, BASE, OUT) do { unsigned a0_ = cvt_pk_bf16(P[BASE + 0], P[BASE + 1]), a1_ = cvt_pk_bf16(P[BASE + 2], P[BASE + 3]);   \
    unsigned b0_ = cvt_pk_bf16(P[BASE + 4], P[BASE + 5]), b1_ = cvt_pk_bf16(P[BASE + 6], P[BASE + 7]);                              \
    auto r0_ = __builtin_amdgcn_permlane32_swap(a0_, b0_, false, false); auto r1_ = __builtin_amdgcn_permlane32_swap(a1_, b1_, false, false); \
    u32x4 w_ = {r0_[0], r1_[0], r0_[1], r1_[1]}; OUT = *reinterpret_cast<bf16x8*>(&w_); } while (0)
template <int OFF> __device__ __forceinline__ bf16x8 k_read(int ka) { bf16x8 r; asm volatile("ds_read_b128 %0, %1 offset:%2" : "=&v"(r) : "v"(ka), "i"(OFF) : "memory"); return r; }
#define LGKM(n) asm volatile("s_waitcnt lgkmcnt(" #n ")" ::: "memory")
template <int KB, bool FIN> __device__ __forceinline__ void qkt_fin(f32x16& n0, f32x16& n1, const int (&ka)[4], const bf16x8* qr,
                                                                    f32x16& f0, f32x16& f1, const float al, float& l_reg, bf16x8& pa0, bf16x8& pa1, bf16x8& pa2, bf16x8& pa3) {
    n0 = f32x16{}; n1 = f32x16{};
    constexpr int H1 = 32 * KROW;
    float ps0 = 0.f, ps1 = 0.f;
#define QSTEP(D, A0, A1, NW) LGKM(NW); SBAR(); n0 = __builtin_amdgcn_mfma_f32_32x32x16_bf16(A0, qr[D], n0, 0, 0, 0); n1 = __builtin_amdgcn_mfma_f32_32x32x16_bf16(A1, qr[D], n1, 0, 0, 0);
#define QLOAD(D, A0, A1) A0 = k_read<KB + ((D) >> 2) * 128>(ka[(D) & 3]); A1 = k_read<KB + H1 + ((D) >> 2) * 128>(ka[(D) & 3]);
#define FEXP(K) if constexpr (FIN) { _Pragma("unroll") for (int r_ = 4 * (K); r_ < 4 * (K) + 4; ++r_) f1[r_] = __builtin_amdgcn_exp2f(f1[r_]); }
    bf16x8 a0, a1, b0, b1, c0, c1;
    QLOAD(0, a0, a1) QLOAD(1, b0, b1) QLOAD(2, c0, c1)
    QSTEP(0, a0, a1, 4) QLOAD(3, a0, a1) FEXP(0)
    QSTEP(1, b0, b1, 4) QLOAD(4, b0, b1) FEXP(1)
    QSTEP(2, c0, c1, 4) QLOAD(5, c0, c1) FEXP(2)
    QSTEP(3, a0, a1, 4) QLOAD(6, a0, a1) FEXP(3)
    QSTEP(4, b0, b1, 4) QLOAD(7, b0, b1)
    if constexpr (FIN) {
#pragma unroll
        for (int r = 0; r < 16; ++r) ps0 += f0[r]; }
    QSTEP(5, c0, c1, 4) QLOAD(8, c0, c1)
    if constexpr (FIN) {
#pragma unroll
        for (int r = 0; r < 16; ++r) ps1 += f1[r]; }
    QSTEP(6, a0, a1, 4) QLOAD(9, a0, a1)
    if constexpr (FIN) { float ps = ps0 + ps1; ps = half_swap_sum(ps); l_reg = l_reg * al + ps; }
    QSTEP(7, b0, b1, 4) QLOAD(10, b0, b1)
    if constexpr (FIN) { PK4(f0, 0, pa0); }
    QSTEP(8, c0, c1, 4) QLOAD(11, c0, c1)
    if constexpr (FIN) { PK4(f0, 8, pa1); }
    QSTEP(9, a0, a1, 4)
    if constexpr (FIN) { PK4(f1, 0, pa2); }
    QSTEP(10, b0, b1, 2)
    if constexpr (FIN) { PK4(f1, 8, pa3); }
    QSTEP(11, c0, c1, 0)
    SBAR();
#undef QSTEP
#undef QLOAD
#undef FEXP
}
__device__ __forceinline__ void finishSM(f32x16& f0, f32x16& f1, const float al, float& l_reg, bf16x8& pa0, bf16x8& pa1, bf16x8& pa2, bf16x8& pa3) {
#pragma unroll
    for (int r = 0; r < 16; ++r) f1[r] = __builtin_amdgcn_exp2f(f1[r]);
    float ps = 0.f;
#pragma unroll
    for (int r = 0; r < 16; ++r) ps += f0[r];
#pragma unroll
    for (int r = 0; r < 16; ++r) ps += f1[r];
    ps = half_swap_sum(ps); l_reg = l_reg * al + ps;
    PK4(f0, 0, pa0); PK4(f0, 8, pa1); PK4(f1, 0, pa2); PK4(f1, 8, pa3);
}
__device__ __forceinline__ float sm_rowmax(const f32x16& s0, const f32x16& s1) {
    float pmax = s0[0];
#pragma unroll
    for (int r = 1; r < 16; ++r) pmax = fmaxf(pmax, s0[r]);
#pragma unroll
    for (int r = 0; r < 16; ++r) pmax = fmaxf(pmax, s1[r]);
    return half_swap_max(pmax);
}
__device__ __forceinline__ void sm_decide(const float pmax, float& m_reg, float& mnC, float& alpha) {
    const bool keep = __all(pmax - m_reg <= THR / SCALE);
    const float mn = keep ? m_reg : fmaxf(m_reg, pmax);
    alpha = keep ? 1.f : __builtin_amdgcn_exp2f((m_reg - mn) * CL2);
    m_reg = mn; mnC = -mn * CL2;
}
__device__ __forceinline__ void partialSM(f32x16& s0, f32x16& s1, float& m_reg, float& alpha) {
    float mnC; sm_decide(sm_rowmax(s0, s1), m_reg, mnC, alpha);
#pragma unroll
    for (int r = 0; r < 16; ++r) s0[r] = fmaf(s0[r], CL2, mnC);
#pragma unroll
    for (int r = 0; r < 16; ++r) s1[r] = fmaf(s1[r], CL2, mnC);
#pragma unroll
    for (int r = 0; r < 16; ++r) s0[r] = __builtin_amdgcn_exp2f(s0[r]);
}
__device__ __forceinline__ int v_st(int k, int c) { const int kk = (k & ~0xC) | ((k & 4) << 1) | ((k & 8) >> 1); return ((kk >> 3) * 4 + (c >> 5)) * 512 + ((kk & 7) * 32 + (c & 31)) * 2; }
__device__ __forceinline__ int v_rd_base(int lane) { return ((lane & 3) << 3) | (((lane >> 2) & 3) << 6) | (((lane >> 4) & 1) << 5) | (((lane >> 5) & 1) << 8); }
constexpr int v_rd_off(int d0, int ks, int half) { return d0 * 512 + ks * 4096 + half * 2048; }
template <int OFF> __device__ __forceinline__ s16x4 tr_read(int vb) {
    s16x4 r; asm volatile("ds_read_b64_tr_b16 %0, %1 offset:%2" : "=&v"(r) : "v"(vb), "i"(OFF) : "memory"); return r;
}
struct VF { s16x4 l0, h0, l1, h1, l2, h2, l3, h3; };
template <int VB, int D0> __device__ __forceinline__ void v_load(VF& f, int vb) {
    f.l0 = tr_read<VB + v_rd_off(D0, 0, 0)>(vb); f.h0 = tr_read<VB + v_rd_off(D0, 0, 1)>(vb); f.l1 = tr_read<VB + v_rd_off(D0, 1, 0)>(vb); f.h1 = tr_read<VB + v_rd_off(D0, 1, 1)>(vb);
    f.l2 = tr_read<VB + v_rd_off(D0, 2, 0)>(vb); f.h2 = tr_read<VB + v_rd_off(D0, 2, 1)>(vb); f.l3 = tr_read<VB + v_rd_off(D0, 3, 0)>(vb); f.h3 = tr_read<VB + v_rd_off(D0, 3, 1)>(vb);
}
__device__ __forceinline__ void v_mma(f32x16& od, const VF& f, bf16x8 pa0, bf16x8 pa1, bf16x8 pa2, bf16x8 pa3) {
#define PK(L, H) (bf16x8){L[0], L[1], L[2], L[3], H[0], H[1], H[2], H[3]}
    od = __builtin_amdgcn_mfma_f32_32x32x16_bf16(PK(f.l0, f.h0), pa0, od, 0, 0, 0);
    od = __builtin_amdgcn_mfma_f32_32x32x16_bf16(PK(f.l1, f.h1), pa1, od, 0, 0, 0);
    od = __builtin_amdgcn_mfma_f32_32x32x16_bf16(PK(f.l2, f.h2), pa2, od, 0, 0, 0);
    od = __builtin_amdgcn_mfma_f32_32x32x16_bf16(PK(f.l3, f.h3), pa3, od, 0, 0, 0);
#undef PK
}
template <int VB, bool PART> __device__ __forceinline__ void pv_part(f32x16* o, int vb, bf16x8 pa0, bf16x8 pa1, bf16x8 pa2, bf16x8 pa3,
                                                                     f32x16& s0, f32x16& s1, float& m_reg, float& alpha) {
    VF fa, fb; float pmax = 0.f, mnC = 0.f;
    v_load<VB, 0>(fa, vb); v_load<VB, 1>(fb, vb);
    LGKM(8); SBAR(); v_mma(o[0], fa, pa0, pa1, pa2, pa3); v_load<VB, 2>(fa, vb);
    if constexpr (PART) pmax = sm_rowmax(s0, s1);
    LGKM(8); SBAR(); v_mma(o[1], fb, pa0, pa1, pa2, pa3); v_load<VB, 3>(fb, vb);
    if constexpr (PART) { sm_decide(pmax, m_reg, mnC, alpha);
#pragma unroll
        for (int r = 0; r < 16; ++r) s0[r] = fmaf(s0[r], CL2, mnC); }
    LGKM(8); SBAR(); v_mma(o[2], fa, pa0, pa1, pa2, pa3);
    if constexpr (PART) {
#pragma unroll
        for (int r = 0; r < 16; ++r) s1[r] = fmaf(s1[r], CL2, mnC);
#pragma unroll
        for (int r = 0; r < 8; ++r) s0[r] = __builtin_amdgcn_exp2f(s0[r]); }
    LGKM(0); SBAR(); v_mma(o[3], fb, pa0, pa1, pa2, pa3);
    if constexpr (PART) {
#pragma unroll
        for (int r = 8; r < 16; ++r) s0[r] = __builtin_amdgcn_exp2f(s0[r]); }
    SBAR();
}

__device__ __forceinline__ void attn_unit(const bf16_t* __restrict__ QAu, const bf16_t* __restrict__ WqTh, const bf16_t* __restrict__ Kb, const bf16_t* __restrict__ WvbPh,
                                          const float* __restrict__ rope, bf16_t* __restrict__ A2u, const int pos0, LAS unsigned char* lds, const int wid) {
    const int lane = lane_id(), tid = wid * 64 + lane, r32 = lane & 31, hi = lane >> 5;
    LAS unsigned char* V_lds = lds + V_OFF; LAS unsigned char* K_lds = lds + K_OFF;
    int ka[4];
    { const int sw = (r32 >> 1) & 7;
#pragma unroll
      for (int q = 0; q < 4; ++q) ka[q] = (int)(unsigned)(uintptr_t)K_lds + r32 * KROW + (((2 * q + hi) ^ sw) << 4); }
    const int vb0 = (int)(unsigned)(uintptr_t)V_lds + v_rd_base(lane);
    int ko[3], vo[2];
#pragma unroll
    for (int i = 0; i < 3; ++i) { const int L = (wid * 3 + i) * 64 + lane, row = L / 24, cp = L % 24, c = (cp & ~7) | ((cp & 7) ^ ((row >> 1) & 7)); ko[i] = row * KROW + c * 16; }
#pragma unroll
    for (int i = 0; i < 2; ++i) { const int B = ((wid * 2 + i) * 64 + lane) * 16, sub = B >> 9, w = (B & 511) >> 1, kk = (sub >> 2) * 8 + (w >> 5);
        const int k = (kk & ~0xC) | ((kk & 4) << 1) | ((kk & 8) >> 1), col = (sub & 3) * 32 + (w & 31); vo[i] = k * KROW + col * 2; }
    const __amdgpu_buffer_rsrc_t krs = __builtin_amdgcn_make_buffer_rsrc((void*)Kb, 0, NKEY * QKD * 2, 0x00020000);
#define DMA(tile, kb, voff) do { const int so_ = (tile) * (KVBLK * KROW);                                                                                          \
        _Pragma("unroll") for (int i_ = 0; i_ < 3; ++i_) __builtin_amdgcn_raw_ptr_buffer_load_lds(krs, (LAS void*)(K_lds + (kb) * SHM_K + (wid * 3 + i_) * 1024), 16, ko[i_], so_, 0, 0); \
        _Pragma("unroll") for (int i_ = 0; i_ < 2; ++i_) __builtin_amdgcn_raw_ptr_buffer_load_lds(krs, (LAS void*)(V_lds + (voff) + (wid * 2 + i_) * 1024), 16, vo[i_], so_, 0, 0); } while (0)
    bf16x8 qr[12];
    { AT_BEGIN(2)
        bf16x8 qb[16]; float ss = 0.f;
        const bf16_t* qrow = QAu + (size_t)wid * 8192 + r32 * 16 + hi * 8;
#pragma unroll
        for (int kk = 0; kk < 16; ++kk) qb[kk] = *(const bf16x8*)(qrow + kk * 512);
#pragma unroll
        for (int kk = 0; kk < 16; ++kk)
#pragma unroll
            for (int j = 0; j < 8; ++j) { const float v = bf2f((bf16_t)qb[kk][j]); ss += v * v; }
        ss = half_swap_sum(ss);
        const float rinv = rsqrtf(ss * (1.f / QL) + EPS);
        const int rsw = (r32 & ~0xC) | ((r32 & 4) << 1) | ((r32 & 8) >> 1);
        const int pos = pos0 + wid * 32 + r32;
        unsigned t16 = (unsigned)tid * 16u; asm volatile("" : "+v"(t16));
        const int wdst = (int)(t16 >> 9) * WPITCH + (int)(t16 & 511u);
        {
            bf16x8 wv[12];
#pragma unroll
            for (int i = 0; i < 12; ++i) wv[i] = *(const bf16x8*)((const char*)WqTh + i * 8192 + t16);
#pragma unroll
            for (int i = 0; i < 12; ++i) *(LAS bf16x8*)(lds + i * 16 * WPITCH + wdst) = wv[i];
        }
        __syncthreads();
        const LAS unsigned char* wl = lds + rsw * WPITCH + hi * 16;
        f32x16 qacc[6];
#pragma unroll
        for (int t = 0; t < 6; ++t) {
            qacc[t] = f32x16{};
#pragma unroll
            for (int kk = 0; kk < 16; ++kk) { const bf16x8 a = *(const LAS bf16x8*)(wl + t * 32 * WPITCH + kk * 32); qacc[t] = __builtin_amdgcn_mfma_f32_32x32x16_bf16(a, qb[kk], qacc[t], 0, 0, 0); }
        }
        asm volatile("s_waitcnt lgkmcnt(0)" ::: "memory"); __syncthreads();
        DMA(0, 0, 0);
#pragma unroll
        for (int t = 0; t < 6; ++t) {
            f32x16 acc = qacc[t];
#pragma unroll
            for (int r = 0; r < 16; ++r) acc[r] *= rinv;
            if (t >= 4) {
                const int pp = (t == 4) ? (pos >> 6) : (pos & 63);
#pragma unroll
                for (int r = 0; r < 8; ++r) { const float2 cs = *(const float2*)(rope + (pp * 16 + 8 * hi + r) * 2);
                    const float x1 = acc[r], x2 = acc[r + 8]; acc[r] = x1 * cs.x - x2 * cs.y; acc[r + 8] = x2 * cs.x + x1 * cs.y; }
            }
            qr[2 * t] = pack8r(acc, 0); qr[2 * t + 1] = pack8r(acc, 8);
        }
      AT_END(2)
    }
#define RESC(a) do { if (__any((a) < 1.f)) { _Pragma("unroll") for (int d = 0; d < 4; ++d) _Pragma("unroll") for (int r = 0; r < 16; ++r) o[d][r] *= (a); } } while (0)
    float m_reg = -1e30f, l_reg = 0.f; f32x16 o[4] = {};
    { AT_BEGIN(1)
    f32x16 pA0, pA1, pB0, pB1; float alA, alB; bf16x8 pa0, pa1, pa2, pa3;
#define VNEXT(R) ((R) == 2 * SHM_V ? 0 : (R) + SHM_V)
#define VWRITE(R) ((R) >= SHM_V ? (R) - SHM_V : (R) + 2 * SHM_V)
    __syncthreads();
    DMA(1, 1, SHM_V);
    qkt_fin<0, false>(pA0, pA1, ka, qr, pB0, pB1, 1.f, l_reg, pa0, pa1, pa2, pa3); partialSM(pA0, pA1, m_reg, alA);
    __syncthreads();
    int R = 0;
    for (int j = 1; j + 1 < NT; j += 2) {
        DMA(j + 1, 0, VWRITE(R));
        SBAR(); qkt_fin<SHM_K, true>(pB0, pB1, ka, qr, pA0, pA1, alA, l_reg, pa0, pa1, pa2, pa3);
        pv_part<0, true>(o, vb0 + R, pa0, pa1, pa2, pa3, pB0, pB1, m_reg, alB);
        RESC(alB); __syncthreads(); R = VNEXT(R);
        DMA(j + 2, 1, VWRITE(R));
        SBAR(); qkt_fin<0, true>(pA0, pA1, ka, qr, pB0, pB1, alB, l_reg, pa0, pa1, pa2, pa3);
        pv_part<0, true>(o, vb0 + R, pa0, pa1, pa2, pa3, pA0, pA1, m_reg, alA);
        RESC(alA); __syncthreads(); R = VNEXT(R);
    }
    SBAR(); qkt_fin<SHM_K, true>(pB0, pB1, ka, qr, pA0, pA1, alA, l_reg, pa0, pa1, pa2, pa3);
    pv_part<0, true>(o, vb0 + R, pa0, pa1, pa2, pa3, pB0, pB1, m_reg, alB);
    RESC(alB); R = VNEXT(R);
    finishSM(pB0, pB1, alB, l_reg, pa0, pa1, pa2, pa3); SBAR();
    pv_part<0, false>(o, vb0 + R, pa0, pa1, pa2, pa3, pB0, pB1, m_reg, alB);
    AT_END(1) }
#undef VNEXT
#undef VWRITE
#undef DMA
#undef RESC
    bf16_t* arow = A2u + (size_t)(wid * 32 + r32) * 3072 + 8 * hi;
    u32x4 gq[8];
#pragma unroll
    for (int i = 0; i < 8; ++i) gq[i] = *(const u32x4*)(arow + 16 * i);
    __syncthreads();
    {
        bf16x8 wv[4];
        unsigned t16 = (unsigned)tid * 16u; asm volatile("" : "+v"(t16));
        const int vdst = (int)(t16 >> 8) * VPITCH + (int)(t16 & 255u);
#pragma unroll
        for (int i = 0; i < 4; ++i) wv[i] = *(const bf16x8*)((const char*)WvbPh + i * 8192 + t16);
#pragma unroll
        for (int i = 0; i < 4; ++i) *(LAS bf16x8*)(lds + i * 32 * VPITCH + vdst) = wv[i];
    }
    const float rl = __builtin_amdgcn_rcpf(l_reg);
    bf16x8 ob[8];
#pragma unroll
    for (int d = 0; d < 4; ++d) {
#pragma unroll
        for (int r = 0; r < 16; ++r) o[d][r] *= rl;
        ob[2 * d] = pack8r(o[d], 0); ob[2 * d + 1] = pack8r(o[d], 8); }
    __syncthreads();
    const LAS unsigned char* vl = lds + r32 * VPITCH + hi * 16;
#pragma unroll
    for (int vt = 0; vt < 4; ++vt) {
        f32x16 at = {};
#pragma unroll
        for (int ks = 0; ks < 8; ++ks) { const bf16x8 a = *(const LAS bf16x8*)(vl + vt * 32 * VPITCH + ks * 32); at = __builtin_amdgcn_mfma_f32_32x32x16_bf16(a, ob[ks], at, 0, 0, 0); }
#pragma unroll
        for (int gp = 0; gp < 2; ++gp) { const u32x4 L = gq[vt * 2 + gp];
            auto q0 = __builtin_amdgcn_permlane32_swap(L.x, L.z, false, false); auto q1 = __builtin_amdgcn_permlane32_swap(L.y, L.w, false, false);
            const int r0 = 8 * gp;
            u32x2 a, b;
            a.x = cvt_pk_bf16(at[r0 + 0] * bflo(q0[0]), at[r0 + 1] * bfhi(q0[0])); a.y = cvt_pk_bf16(at[r0 + 2] * bflo(q1[0]), at[r0 + 3] * bfhi(q1[0]));
            b.x = cvt_pk_bf16(at[r0 + 4] * bflo(q0[1]), at[r0 + 5] * bfhi(q0[1])); b.y = cvt_pk_bf16(at[r0 + 6] * bflo(q1[1]), at[r0 + 7] * bfhi(q1[1]));
            auto s0 = __builtin_amdgcn_permlane32_swap(a.x, b.x, false, false); auto s1 = __builtin_amdgcn_permlane32_swap(a.y, b.y, false, false);
            *(u32x4*)(arow + 16 * (vt * 2 + gp)) = (u32x4){s0[0], s1[0], s0[1], s1[1]}; }
    }
    __syncthreads();
}
#undef SBAR
#undef LGKM
#undef PK4
}

__device__ __forceinline__ void p5_attn(const Params& P, LAS unsigned char* lds, const int wid) {
    const int G = gridDim.x, c = blockIdx.x;
    const bf16_t* QA = (const bf16_t*)(P.ws + WS_QA); const bf16_t* WqT = (const bf16_t*)(P.ws + WS_WQT); const bf16_t* KC = (const bf16_t*)(P.ws + WS_KC);
    const bf16_t* WvbP = (const bf16_t*)(P.ws + WS_WVBT); const float* rope = (const float*)(P.ws + WS_ROPE); bf16_t* A2 = (bf16_t*)(P.ws + WS_CAT);
    constexpr int NU = NB * NH * (S / 256);
    for (int i = 0; ; ++i) {
        const int L = i * G + c; if (L >= NU) break;
        int b, h, qt;
        if (G == 256) { const int x = c & 7, loc = (i & 3) * 32 + (c >> 3); b = 2 * x + (i >> 2); h = loc >> 3; qt = loc & 7; }
        else { b = L / (NH * 8); h = (L >> 3) % NH; qt = L & 7; }
        const int tok0 = b * S + qt * 256;
        att::attn_unit(QA + (size_t)tok0 * QL, WqT + (size_t)h * QKD * QL, KC + (size_t)b * NKEY * QKD, WvbP + (size_t)h * VD * KVL, rope,
                       A2 + (size_t)tok0 * 3072 + 1024 + h * VD, qt * 256, lds, wid);
    }
}

__device__ __forceinline__ void p8_final(const Params& P, const int wave) {
    const int lane = lane_id(), gw = blockIdx.x * NWAVES + wave, NGW = gridDim.x * NWAVES;
    const bf16_t* GY = (const bf16_t*)(P.ws + WS_U);
    f32x4 g[4];
#pragma unroll
    for (int j = 0; j < 4; ++j) g[j] = *(const f32x4*)(P.final_g + 256 * j + 4 * lane);
    for (int row0 = 4 * gw; row0 < M; row0 += 4 * NGW) {
        f32x4 v[4][4]; float ss[4];
#pragma unroll
        for (int u = 0; u < 4; ++u) { const int row = row0 + u; const float* px = P.x + (size_t)row * D; const bf16_t* pg = GY + (size_t)row * D; ss[u] = 0.f;
#pragma unroll
            for (int j = 0; j < 4; ++j) { v[u][j] = __builtin_nontemporal_load((const f32x4*)(px + 256 * j + 4 * lane)) + ld4bf(pg + 256 * j + 4 * lane);
                ss[u] += v[u][j][0] * v[u][j][0] + v[u][j][1] * v[u][j][1] + v[u][j][2] * v[u][j][2] + v[u][j][3] * v[u][j][3]; } }
#pragma unroll
        for (int u = 0; u < 4; ++u) { float* p = P.out + (size_t)(row0 + u) * D; const float rinv = rsqrtf(wave_sum(ss[u]) * (1.f / D) + EPS);
#pragma unroll
            for (int j = 0; j < 4; ++j) __builtin_nontemporal_store(v[u][j] * rinv * g[j], (f32x4*)(p + 256 * j + 4 * lane)); }
    }
}

#ifndef PROBE_MASK
#define PROBE_MASK 0
#endif
#ifndef PROBE_ATTN
#define PROBE_ATTN 0
#endif
#define PH_BEGIN(k) unsigned long long t0_##k = 0; if ((PROBE_MASK >> (k)) & 1) t0_##k = __builtin_amdgcn_s_memrealtime();
#define PH_END(k) if ((PROBE_MASK >> (k)) & 1) { const unsigned long long t1_ = __builtin_amdgcn_s_memrealtime(); while (__builtin_amdgcn_s_memrealtime() - t1_ < t1_ - t0_##k) __builtin_amdgcn_s_sleep(16); }
__global__ void __launch_bounds__(NTHREADS, 2) fwd_megakernel(Params P) {
    extern __shared__ __attribute__((aligned(16))) unsigned char lds[];
    cg::grid_group grid = cg::this_grid();
    LAS unsigned char* ldsl = (LAS unsigned char*)lds;
    unsigned char* ws = P.ws; const int G = gridDim.x, bid = blockIdx.x, wid = __builtin_amdgcn_readfirstlane(threadIdx.x >> 6);
    bf16_t* WINT = (bf16_t*)(ws + WS_WINT); bf16_t* WCAT = (bf16_t*)(ws + WS_WCAT); bf16_t* WOUT = (bf16_t*)(ws + WS_WOUT);
    bf16_t* UW = (bf16_t*)(ws + WS_U); bf16_t* SGP = (bf16_t*)(ws + WS_SGP); bf16_t* CAT = (bf16_t*)(ws + WS_CAT); bf16_t* QA = (bf16_t*)(ws + WS_QA);
    bf16_t* GMP = (bf16_t*)(ws + WS_GMP); bf16_t* GMM = (bf16_t*)(ws + WS_GMM); float* KVA = (float*)((unsigned char*)P.out + OUT_KVA);
    bf16_t* H = (bf16_t*)P.out; bf16_t* Z = SGP;
    volatile LAS unsigned* st = (volatile LAS unsigned*)(ldsl + LDS_BYTES - 16);
    if (threadIdx.x < 4) st[threadIdx.x] = 0u;
    __syncthreads();
    XcdBarrier xb; xb.bar = (unsigned*)(ws + WS_BAR); xb.x = xb_xcc_id(); xb.st = st;
    if (threadIdx.x == 0) (void)xb_add(&xb.bar[XB_XCNT(xb.x)], 1u);
#define GRID_BAR() xcd_barrier(xb, wid)
    PH_BEGIN(0) p0_prep(P, lds, ldsl, wid); PH_END(0)
    if (P.ws == nullptr) grid.sync();
    const bool split = false;
    pg8::Epi1 e1{UW, SGP, QA, CAT, GMP, GMM, KVA, P.b_gate};
    PH_BEGIN(1) p1_h(P, wid); PH_END(1)
    GRID_BAR();
    PH_BEGIN(2)
    {
        pg8::Gemm g{H, WINT, 1024, 1024, 1024, 0}; pg8::StaticOrder so; so.init(M / 256, N1 / 256, G, bid, split ? 0 : MC / 256);
        pg8::gemm_phase(ldsl, g, so, e1, wid);
    }
    PH_END(2)
    GRID_BAR();
    PH_BEGIN(3) p3_thin(P, wid, ldsl, split, e1); PH_END(3)
    GRID_BAR();
    PH_BEGIN(5) p5_attn(P, ldsl, wid); PH_END(5)
    GRID_BAR();
    PH_BEGIN(6)
    {
        pg8::Gemm g{CAT, WCAT, 3072, 3072, 3072, 0}; pg8::StaticOrder so; so.init(M / 256, 4, G, bid, 0);
        pg8::Epi3 e{GMM, Z}; pg8::Hook3 hk{GMP, GMM};
        pg8::gemm_phase(ldsl, g, so, e, wid, hk);
    }
    PH_END(6)
    GRID_BAR();
    PH_BEGIN(7)
    {
        pg8::Gemm g{Z, WOUT, 1024, 1024, 1024, 0}; pg8::StaticOrder so; so.init(M / 256, 4, G, bid, 0);
        pg8::Epi4 e{(const float*)(ws + WS_ADA), UW};
        pg8::gemm_phase(ldsl, g, so, e, wid);
    }
    PH_END(7)
    GRID_BAR();
    PH_BEGIN(8) p8_final(P, wid); PH_END(8)
}

extern "C" void kernel_launch(void* const* d_in, const int* in_sizes, int n_in, void* d_out, int out_size, void* d_ws, size_t ws_size, hipStream_t stream) {
    static int grid_blocks = 0;
    if (grid_blocks == 0) {
        if (n_in != 19 || out_size != M * D || ws_size < WS_END) { fprintf(stderr, "kernel_launch: unexpected shapes (n_in %d out %d ws %zu need %zu)\n", n_in, out_size, ws_size, (size_t)WS_END); grid_blocks = -1; return; }
        int dev = 0, cus = 0, per_cu = 0;
        (void)hipGetDevice(&dev); (void)hipDeviceGetAttribute(&cus, hipDeviceAttributeMultiprocessorCount, dev);
        if (hipFuncSetAttribute((const void*)fwd_megakernel, hipFuncAttributeMaxDynamicSharedMemorySize, LDS_BYTES) != hipSuccess) { fprintf(stderr, "kernel_launch: hipFuncSetAttribute failed\n"); grid_blocks = -1; return; }
        if (hipOccupancyMaxActiveBlocksPerMultiprocessor(&per_cu, (const void*)fwd_megakernel, NTHREADS, LDS_BYTES) != hipSuccess || per_cu < 1) { fprintf(stderr, "kernel_launch: occupancy query failed (%d)\n", per_cu); grid_blocks = -1; return; }
        grid_blocks = cus * 1;
        fprintf(stderr, "kernel_launch: cus %d per_cu %d grid %d\n", cus, per_cu, grid_blocks);
    }
    if (grid_blocks < 0) return;
    Params p{};
    const float** pf = (const float**)&p;
    for (int i = 0; i < 19; ++i) pf[i] = (const float*)d_in[i];
    p.out = (float*)d_out; p.ws = (unsigned char*)d_ws;
    if (hipMemsetAsync((char*)d_ws + WS_BAR, 0, BAR_BYTES, stream) != hipSuccess) { fprintf(stderr, "kernel_launch: memset failed\n"); return; }
    void* args[] = {&p};
    hipError_t e = hipLaunchCooperativeKernel((const void*)fwd_megakernel, dim3(grid_blocks), dim3(NTHREADS), args, LDS_BYTES, stream);
    if (e != hipSuccess) fprintf(stderr, "kernel_launch: cooperative launch failed: %s (grid %d)\n", hipGetErrorString(e), grid_blocks);
}
```

```cpp
#include <hip/hip_runtime.h>
#include <hip/hip_cooperative_groups.h>
#include <cstdint>
#include <cstdio>
namespace cg = cooperative_groups;

#ifndef PROBE_ATTN
#define PROBE_ATTN 0
#endif
#define AT_BEGIN(k) unsigned long long at0_ = 0; if (PROBE_ATTN == (k)) at0_ = __builtin_amdgcn_s_memrealtime();
#define AT_END(k) if (PROBE_ATTN == (k)) { const unsigned long long t1_ = __builtin_amdgcn_s_memrealtime(); while (__builtin_amdgcn_s_memrealtime() - t1_ < t1_ - at0_) __builtin_amdgcn_s_sleep(8); }
typedef unsigned short bf16_t;
typedef short bf16x8 __attribute__((ext_vector_type(8)));
typedef float f32x4 __attribute__((ext_vector_type(4)));
typedef unsigned u32x4 __attribute__((ext_vector_type(4)));
typedef unsigned u32x2 __attribute__((ext_vector_type(2)));
#define LAS __attribute__((address_space(3)))

constexpr int D = 1024, NB = 16, S = 2048, CTX = 256, M = NB * S, MC = NB * CTX, MT = M + MC, NKEY = S + CTX;
constexpr int NH = 16, QKN = 128, QKR = 64, VD = 128, QL = 256, KVL = 128, QKD = QKN + QKR;
constexpr int INW = 6592, N1 = 6656;
constexpr int C_U = 0, C_GP = 1024, C_QA = 2048, C_GM = 2304, C_MP = 4352, C_MM = 5376, C_KV = 6400;
constexpr float EPS = 1e-6f;
constexpr int NTHREADS = 512, NWAVES = 8;
constexpr int LDS_BYTES = 147456;

constexpr size_t al256(size_t x) { return (x + 255) / 256 * 256; }
constexpr size_t WS_ADA   = 0;
constexpr size_t WS_ROPE  = WS_ADA   + al256((size_t)17 * 3072 * 4);
constexpr size_t WS_WINT  = WS_ROPE  + al256((size_t)64 * 16 * 2 * 4);
constexpr size_t WS_WCAT  = WS_WINT  + al256((size_t)N1 * D * 2);
constexpr size_t WS_WOUT  = WS_WCAT  + al256((size_t)1024 * 3072 * 2);
constexpr size_t WS_WQT   = WS_WOUT  + al256((size_t)1024 * 1024 * 2);
constexpr size_t WS_WVBT  = WS_WQT   + al256((size_t)NH * QKD * QL * 2);
constexpr size_t WS_U     = WS_WVBT  + al256((size_t)NH * VD * KVL * 2);
constexpr size_t WS_SGP   = WS_U     + al256((size_t)M * 1024 * 2);
constexpr size_t WS_CAT   = WS_SGP   + al256((size_t)M * 1024 * 2);
constexpr size_t WS_QA    = WS_CAT   + al256((size_t)M * 3072 * 2);
constexpr size_t WS_GMP   = WS_QA    + al256((size_t)M * 256 * 2);
constexpr size_t WS_GMM   = WS_GMP   + al256((size_t)M * 1024 * 2);
constexpr size_t WS_KC    = WS_GMM   + al256((size_t)M * 1024 * 2);
constexpr size_t WS_BAR   = WS_KC    + al256((size_t)NB * NKEY * QKD * 2);
constexpr size_t OUT_KVA  = (size_t)80 << 20;
constexpr size_t BAR_BYTES = 16384;
constexpr int ADA_CNT_WORD = 3584;
constexpr size_t WS_END   = WS_BAR   + BAR_BYTES;

struct Params {
    const float *x, *c, *ctx, *c_ctx, *ada_w, *ada_b, *norm_g, *w_in, *b_gate, *w_pool, *pool_scale, *q_norm_g, *w_qb, *kv_norm_g, *w_kvb, *w_pp, *w_pm, *w_out, *final_g;
    float* out; unsigned char* ws;
};

__device__ __forceinline__ bf16_t f2bf(float f) { unsigned u = __float_as_uint(f); u += 0x7fffu + ((u >> 16) & 1u); return (bf16_t)(u >> 16); }
__device__ __forceinline__ float bf2f(bf16_t b) { return __uint_as_float(((unsigned)b) << 16); }
__device__ __forceinline__ float bflo(unsigned w) { return __uint_as_float(w << 16); }
__device__ __forceinline__ float bfhi(unsigned w) { return __uint_as_float(w & 0xffff0000u); }
__device__ __forceinline__ u32x2 cvt2_pk_bf16(float a0, float a1, float a2, float a3) { u32x2 r;
    asm volatile("s_nop 0\n\tv_cvt_pk_bf16_f32 %0, %2, %3\n\tv_cvt_pk_bf16_f32 %1, %4, %5" : "=&v"(r.x), "=v"(r.y) : "v"(a0), "v"(a1), "v"(a2), "v"(a3)); return r; }
__device__ __forceinline__ u32x4 cvt4_pk_bf16(float a0, float a1, float a2, float a3, float a4, float a5, float a6, float a7) { u32x4 r;
    asm volatile("s_nop 0\n\tv_cvt_pk_bf16_f32 %0, %4, %5\n\tv_cvt_pk_bf16_f32 %1, %6, %7\n\tv_cvt_pk_bf16_f32 %2, %8, %9\n\tv_cvt_pk_bf16_f32 %3, %10, %11"
                 : "=&v"(r.x), "=&v"(r.y), "=&v"(r.z), "=v"(r.w) : "v"(a0), "v"(a1), "v"(a2), "v"(a3), "v"(a4), "v"(a5), "v"(a6), "v"(a7)); return r; }
__device__ __forceinline__ float siluf(float v) { return v / (1.f + __expf(-v)); }
__device__ __forceinline__ float sigmf(float v) { return 1.f / (1.f + __expf(-v)); }
__device__ __forceinline__ int lane_id() { unsigned z = 0u; asm volatile("" : "+v"(z)); return (int)__builtin_amdgcn_mbcnt_hi(~0u, __builtin_amdgcn_mbcnt_lo(~0u, z)); }
template <int K> __device__ __forceinline__ float swz_xor(float v) { return __uint_as_float((unsigned)__builtin_amdgcn_ds_swizzle((int)__float_as_uint(v), (K << 10) | 0x1f)); }
__device__ __forceinline__ float half_swap_sum(float v) { auto rr = __builtin_amdgcn_permlane32_swap(__float_as_uint(v), __float_as_uint(v), false, false); return __uint_as_float(rr[0]) + __uint_as_float(rr[1]); }
__device__ __forceinline__ float half_swap_max(float v) { auto rr = __builtin_amdgcn_permlane32_swap(__float_as_uint(v), __float_as_uint(v), false, false); return fmaxf(__uint_as_float(rr[0]), __uint_as_float(rr[1])); }
__device__ __forceinline__ float wave_sum(float v) {
    v += swz_xor<1>(v); v += swz_xor<2>(v); v += swz_xor<4>(v); v += swz_xor<8>(v); v += swz_xor<16>(v);
    return half_swap_sum(v);
}
__device__ __forceinline__ float wave_max(float v) {
    v = fmaxf(v, swz_xor<1>(v)); v = fmaxf(v, swz_xor<2>(v)); v = fmaxf(v, swz_xor<4>(v)); v = fmaxf(v, swz_xor<8>(v)); v = fmaxf(v, swz_xor<16>(v));
    return half_swap_max(v);
}

#define XB_TMO      128
#define XB_XCNT(j)  (256  + 64 * (j))
#define XB_XSUB(j)  (1280 + 64 * (j))
#define XB_XGEN(j)  (2304 + 64 * (j))
#define XB_TOP      3328
#define XB_TOPGEN   3392
#define XB_SPIN_CAP (1u << 24)
__device__ __forceinline__ unsigned xb_ld(unsigned* p)              { return __hip_atomic_load(p, __ATOMIC_RELAXED, __HIP_MEMORY_SCOPE_AGENT); }
__device__ __forceinline__ unsigned xb_add(unsigned* p, unsigned v) { return __hip_atomic_fetch_add(p, v, __ATOMIC_RELAXED, __HIP_MEMORY_SCOPE_AGENT); }
__device__ __forceinline__ unsigned xb_xcc_id() { return (unsigned)__builtin_amdgcn_s_getreg((3 << 11) | 20) & 0xFu; }
#define XB_SPIN(cond, bar) do { unsigned _sp = 0; while (cond) { __builtin_amdgcn_s_sleep(1); \
    if ((++_sp & 255u) == 0u) { if (xb_ld(&(bar)[XB_TMO])) break; if (_sp > XB_SPIN_CAP) { atomicAdd(&(bar)[XB_TMO], 1u); break; } } } } while (0)
struct XcdBarrier { unsigned* bar; unsigned x; volatile LAS unsigned* st; };
__device__ __forceinline__ void xcd_barrier_complete(unsigned* bar, unsigned x, unsigned& nloc, unsigned& nx) {
    const unsigned G = gridDim.x * gridDim.y * gridDim.z;
    unsigned sum, cnt, mine, sp = 0u;
    for (;;) {
        sum = 0u; cnt = 0u; mine = 0u;
#pragma unroll
        for (unsigned j = 0; j < 16; ++j) { const unsigned c = xb_ld(&bar[XB_XCNT(j)]); sum += c; cnt += (c > 0u) ? 1u : 0u; mine = (j == x) ? c : mine; }
        if (sum == G) break;
        __builtin_amdgcn_s_sleep(1);
        if ((++sp & 255u) == 0u) { if (xb_ld(&bar[XB_TMO])) break; if (sp > XB_SPIN_CAP) { atomicAdd(&bar[XB_TMO], 1u); break; } }
    }
    nloc = mine > 0u ? mine : 1u; nx = cnt > 0u ? cnt : 1u;
}
__device__ __forceinline__ void xcd_barrier(const XcdBarrier& b, const int wid) {
    const bool leader = (wid == 0) && (lane_id() == 0);
    asm volatile("s_waitcnt vmcnt(0)" ::: "memory");
    __syncthreads();
    if (leader) {
        unsigned* bar = b.bar;
        __builtin_amdgcn_s_waitcnt(0);
        unsigned nloc = b.st[0], nx = b.st[1];
        if (nloc == 0u) { xcd_barrier_complete(bar, b.x, nloc, nx); b.st[0] = nloc; b.st[1] = nx; }
        const unsigned old = xb_add(&bar[XB_XSUB(b.x)], 1u);
        const unsigned gen = old / nloc;
        if (old + 1u == (gen + 1u) * nloc) {
            __builtin_amdgcn_fence(__ATOMIC_RELEASE, "agent");
            asm volatile("s_waitcnt vmcnt(0)" ::: "memory");
            const unsigned og = xb_add(&bar[XB_TOP], 1u);
            const unsigned tg = og / nx;
            if (og + 1u == (tg + 1u) * nx) xb_add(&bar[XB_TOPGEN], 1u);
            else XB_SPIN(xb_ld(&bar[XB_TOPGEN]) == tg, bar);
            __builtin_amdgcn_fence(__ATOMIC_ACQUIRE, "agent");
            xb_add(&bar[XB_XGEN(b.x)], 1u);
            asm volatile("s_waitcnt vmcnt(0)" ::: "memory");
        } else {
            XB_SPIN(xb_ld(&bar[XB_XGEN(b.x)]) == gen, bar);
            __builtin_amdgcn_fence(__ATOMIC_ACQUIRE, "agent");
            asm volatile("s_waitcnt vmcnt(0)" ::: "memory");
        }
    }
    __syncthreads();
}

namespace pg8 {
constexpr int BM = 256, BK = 64, HALF = 128, HTB = HALF * BK * 2  , NXCD = 8, WGM = 8;
__host__ __device__ __forceinline__ int lds_byte(int r, int c) { const int st = (r >> 4) * 2 + (c >> 5), rr = r & 15, cc = c & 31, ob = rr * 64 + cc * 2; return st * 1024 + (ob ^ (((ob >> 9) & 1) << 5)); }
__host__ __device__ __forceinline__ void stage_rc(int b, int& R, int& C) { const int st = b / 1024, sb = b % 1024, swz = sb ^ (((sb >> 9) & 1) << 5); R = (st >> 1) * 16 + swz / 64; C = (st & 1) * 32 + (swz % 64) / 2; }
__host__ __device__ __forceinline__ int perm32(int rho) { const int n = rho >> 4, i = rho & 15; return 8 * (i >> 2) + 4 * n + (i & 3); }

struct Unit { int pm, pn; };
struct Gemm { const bf16_t* A; const bf16_t* Bt; int lda, ldb, K, a_koff_pn; };

struct StaticOrder {
    int nM, nN, nwg, G, c, extra;
    __device__ void init(int nM_, int nN_, int G_, int c_, int extra_) { nM = nM_; nN = nN_; nwg = nM * nN; G = G_; c = c_; extra = extra_; }
    __device__ bool next(int i, Unit& u) const {
        const long L = (long)i * G + c; if (L >= nwg + extra) return false;
        if (L >= nwg) { u.pm = nM + (int)(L - nwg); u.pn = nN - 1; return true; }
        int wgid = (int)L; { const int q = nwg / NXCD, r = nwg % NXCD, xcd = wgid % NXCD, off = wgid / NXCD; wgid = (xcd < r ? xcd * (q + 1) : r * (q + 1) + (xcd - r) * q) + off; }
        const int nig = WGM * nN, gid = wgid / nig, fm = gid * WGM, gsz = (nM - fm) < WGM ? (nM - fm) : WGM;
        u.pm = fm + ((wgid % nig) % gsz); u.pn = (wgid % nig) / gsz; return true;
    }
};

typedef f32x4 Acc[2][2][4][2];

struct NoHook { static constexpr int T = -1; __device__ __forceinline__ void operator()(Acc&, const Unit&, int, int, int, int) const {} };
struct OneUnit { Unit u; __device__ bool next(int i, Unit& o) const { if (i != 0) return false; o = u; return true; } };
template <class Epi, class Hook = NoHook, class Sched = StaticOrder>
__device__ __forceinline__ void gemm_phase(LAS unsigned char* lds, const Gemm g, const Sched& S, const Epi& E, const int wid, const Hook& H = Hook()) {
    const int lane = lane_id(), tid = wid * 64 + lane, wr = wid >> 2, wc = wid & 3, fr = lane & 15, fq = lane >> 4;
    const int K = g.K, nt = K / BK;
    unsigned voffA[2], voffB[2];
#pragma unroll
    for (int i = 0; i < 2; ++i) { int R, C; stage_rc(tid * 16 + i * 8192, R, C); const int Rb = (R & ~31) + perm32(R & 31);
        voffA[i] = (unsigned)(R * g.lda + C) * 2u; voffB[i] = (unsigned)(Rb * g.ldb + C) * 2u; }
    const size_t kstep = (size_t)(BK * 2);
    const size_t hstepA = (size_t)HALF * g.lda * 2, hstepB = (size_t)HALF * g.ldb * 2;
    const size_t tstepA = 2 * hstepA, tstepB = 2 * hstepB;
    const unsigned ldsw = (unsigned)wid * 1024u;
    const int aoff = lds_byte(wr * 64 + fr, fq * 8), boff = lds_byte(wc * 32 + fr, fq * 8);
#define PG8_SA(b, h) (((b) * 2 + (h)) * HTB)
#define PG8_SB(b, h) ((4 + (b) * 2 + (h)) * HTB)
#define PG8_STAGE(bufoff, gbase, voff) do { _Pragma("unroll") for (int _i = 0; _i < 2; ++_i) \
        __builtin_amdgcn_global_load_lds((const unsigned*)((const char*)(gbase) + (voff)[_i]), (LAS unsigned*)(lds + (bufoff) + ldsw + _i * 8192), 16, 0, 0); } while (0)
#define PG8_LDA(dst, b, h) do { _Pragma("unroll") for (int m = 0; m < 4; ++m) _Pragma("unroll") for (int k = 0; k < 2; ++k) dst[m][k] = *(const LAS bf16x8*)(lds + PG8_SA(b, h) + aoff + m * 2048 + k * 1024); } while (0)
#define PG8_LDB(dst, b, h) do { _Pragma("unroll") for (int n = 0; n < 2; ++n) _Pragma("unroll") for (int k = 0; k < 2; ++k) dst[n][k] = *(const LAS bf16x8*)(lds + PG8_SB(b, h) + boff + n * 2048 + k * 1024); } while (0)
#define PG8_MMA(ai, bj, At, Bt) do { __builtin_amdgcn_s_setprio(1); _Pragma("unroll") for (int m = 0; m < 4; ++m) _Pragma("unroll") for (int n = 0; n < 2; ++n) _Pragma("unroll") for (int k = 0; k < 2; ++k) \
        acc[ai][bj][m][n] = __builtin_amdgcn_mfma_f32_16x16x32_bf16(Bt[n][k], At[m][k], acc[ai][bj][m][n], 0, 0, 0); __builtin_amdgcn_s_setprio(0); } while (0)
#define PG8_WAIT_V(n) asm volatile("s_waitcnt vmcnt(" #n ")" ::: "memory")
#define PG8_WAIT_L(n) asm volatile("s_waitcnt lgkmcnt(" #n ")" ::: "memory")
#define PG8_BAR __builtin_amdgcn_s_barrier()
#define PG8_SCHED __builtin_amdgcn_sched_barrier(0)
    Unit cur, nxt; int ui = 0;
    if (!S.next(0, cur)) return;
    Acc acc;
#pragma unroll
    for (int a = 0; a < 2; ++a)
#pragma unroll
        for (int b = 0; b < 2; ++b)
#pragma unroll
            for (int m = 0; m < 4; ++m)
#pragma unroll
                for (int n = 0; n < 2; ++n) acc[a][b][m][n] = (f32x4){0.f, 0.f, 0.f, 0.f};
    bf16x8 At[4][2], B0[2][2], B1[2][2];
    const char* cA = (const char*)g.A + (size_t)cur.pm * tstepA + (size_t)cur.pn * g.a_koff_pn * 2; const char* cB = (const char*)g.Bt + (size_t)cur.pn * tstepB;
    PG8_STAGE(PG8_SB(0, 0), cB, voffB); PG8_STAGE(PG8_SB(0, 1), cB + hstepB, voffB); PG8_STAGE(PG8_SA(0, 0), cA, voffA); PG8_STAGE(PG8_SA(0, 1), cA + hstepA, voffA);
    if (wr == 1) PG8_BAR;
    PG8_WAIT_V(2); PG8_BAR;
    PG8_STAGE(PG8_SB(1, 0), cB + kstep, voffB); PG8_STAGE(PG8_SA(1, 0), cA + kstep, voffA); PG8_STAGE(PG8_SB(1, 1), cB + hstepB + kstep, voffB);
    PG8_WAIT_V(6); PG8_BAR;
    for (;;) {
        const bool has_next = S.next(ui + 1, nxt);
        const char* nA = has_next ? (const char*)g.A + (size_t)nxt.pm * tstepA + (size_t)nxt.pn * g.a_koff_pn * 2 : cA; const char* nB = has_next ? (const char*)g.Bt + (size_t)nxt.pn * tstepB : cB;
        for (int t = 0; t < nt; t += 2) {
            const bool last = (t == nt - 2);
            const char* a1 = cA + (size_t)(t + 1) * kstep;
            const char* a2 = last ? nA : cA + (size_t)(t + 2) * kstep; const char* b2 = last ? nB : cB + (size_t)(t + 2) * kstep;
            const char* a3 = a2 + kstep; const char* b3 = b2 + kstep;
            if constexpr (Hook::T >= 0) { if (t == Hook::T) H(acc, cur, wr, wc, fr, fq); }
            PG8_LDB(B0, 0, 0); PG8_LDB(B1, 0, 1); PG8_SCHED; PG8_LDA(At, 0, 0); PG8_STAGE(PG8_SA(1, 1), a1 + hstepA, voffA);
            PG8_WAIT_V(8); PG8_WAIT_L(0); PG8_BAR; PG8_MMA(0, 0, At, B0); PG8_MMA(0, 1, At, B1); PG8_BAR; PG8_SCHED;
            PG8_LDA(At, 0, 1); PG8_STAGE(PG8_SB(0, 0), b2, voffB); PG8_STAGE(PG8_SB(0, 1), b2 + hstepB, voffB); PG8_STAGE(PG8_SA(0, 0), a2, voffA);
            PG8_WAIT_V(8); PG8_WAIT_L(0); PG8_BAR; PG8_MMA(1, 0, At, B0); PG8_MMA(1, 1, At, B1); PG8_BAR; PG8_SCHED;
            PG8_LDB(B0, 1, 0); PG8_LDB(B1, 1, 1); PG8_SCHED; PG8_LDA(At, 1, 0); PG8_STAGE(PG8_SA(0, 1), a2 + hstepA, voffA);
            PG8_WAIT_V(8); PG8_WAIT_L(0); PG8_BAR; PG8_MMA(0, 0, At, B0); PG8_MMA(0, 1, At, B1); PG8_BAR; PG8_SCHED;
            PG8_LDA(At, 1, 1); PG8_STAGE(PG8_SB(1, 0), b3, voffB); PG8_STAGE(PG8_SB(1, 1), b3 + hstepB, voffB); PG8_STAGE(PG8_SA(1, 0), a3, voffA);
            PG8_WAIT_V(8); PG8_WAIT_L(0); PG8_BAR; PG8_MMA(1, 0, At, B0); PG8_MMA(1, 1, At, B1); PG8_BAR; PG8_SCHED;
        }
        if (wr == 0) PG8_BAR;
        E(acc, cur, wr, wc, fr, fq);
        if (!has_next) break;
#pragma unroll
        for (int a = 0; a < 2; ++a)
#pragma unroll
            for (int b = 0; b < 2; ++b)
#pragma unroll
                for (int m = 0; m < 4; ++m)
#pragma unroll
                    for (int n = 0; n < 2; ++n) acc[a][b][m][n] = (f32x4){0.f, 0.f, 0.f, 0.f};
        cur = nxt; cA = nA; cB = nB; ++ui;
        if (wr == 1) PG8_BAR;
    }
    PG8_WAIT_V(0);
    PG8_BAR;
#undef PG8_SA
#undef PG8_SB
#undef PG8_STAGE
#undef PG8_LDA
#undef PG8_LDB
#undef PG8_MMA
#undef PG8_WAIT_V
#undef PG8_WAIT_L
#undef PG8_BAR
#undef PG8_SCHED
}

#define EPI_FOREACH(...) _Pragma("unroll") for (int ai = 0; ai < 2; ++ai) _Pragma("unroll") for (int m = 0; m < 4; ++m) { const int row = u.pm * BM + ai * HALF + wr * 64 + m * 16 + fr; \
        _Pragma("unroll") for (int bj = 0; bj < 2; ++bj) { const int ct = bj * HALF + wc * 32 + 8 * fq; const f32x4 v0 = acc[ai][bj][m][0], v1 = acc[ai][bj][m][1]; __VA_ARGS__ } }
__device__ __forceinline__ u32x4 pack8(const f32x4 a, const f32x4 b) { return cvt4_pk_bf16(a[0], a[1], a[2], a[3], b[0], b[1], b[2], b[3]); }
__device__ __forceinline__ void unpack8(const u32x4 w, f32x4& a, f32x4& b) { a = (f32x4){bflo(w.x), bfhi(w.x), bflo(w.y), bfhi(w.y)}; b = (f32x4){bflo(w.z), bfhi(w.z), bflo(w.w), bfhi(w.w)}; }
__device__ __forceinline__ f32x4 act4(f32x4 v, int mode) {
    f32x4 o;
#pragma unroll
    for (int j = 0; j < 4; ++j) { const float s = __builtin_amdgcn_rcpf(1.f + __expf(-v[j])); o[j] = mode == 1 ? v[j] * s : s; }
    return o;
}
struct Epi1 {
    bf16_t *UW, *SGP, *QA, *CAT, *GMP, *GMM; float* KVA; const float* b_gate;
    __device__ __forceinline__ void operator()(const Acc& acc, const Unit& u, int wr, int wc, int fr, int fq) const {
        const int pn = u.pn;
        if (pn == 8) {
            EPI_FOREACH({ *(u32x4*)(QA + ((size_t)(row >> 5) * 8192 + (size_t)(ct >> 4) * 512 + (size_t)(row & 31) * 16 + (ct & 8))) = pack8(v0, v1); }) return; }
        if (pn == 25) { EPI_FOREACH({ float* p = KVA + (size_t)row * 256 + ct; *(f32x4*)p = v0; *(f32x4*)(p + 4) = v1; }) return; }
        bf16_t* base; int ld, c0, mode = 0; const float* bias = nullptr;
        if (pn < 4) { base = UW; ld = 1024; c0 = pn * 256; }
        else if (pn < 8) { base = SGP; ld = 1024; c0 = (pn - 4) * 256; mode = 1; }
        else if (pn < 9) { base = QA; ld = 256; c0 = 0; }
        else if (pn < 17) { base = CAT; ld = 3072; c0 = 1024 + (pn - 9) * 256; mode = 1; }
        else if (pn < 21) { base = GMP; ld = 1024; c0 = (pn - 17) * 256; mode = 2; bias = b_gate + c0; }
        else { base = GMM; ld = 1024; c0 = (pn - 21) * 256; mode = 2; bias = b_gate + 1024 + c0; }
        if (mode == 0) { EPI_FOREACH({ *(u32x4*)(base + (size_t)row * ld + c0 + ct) = pack8(v0, v1); }) }
        else if (mode == 1) { EPI_FOREACH({ *(u32x4*)(base + (size_t)row * ld + c0 + ct) = pack8(act4(v0, 1), act4(v1, 1)); }) }
        else { f32x4 bb[2][2];
#pragma unroll
               for (int bj = 0; bj < 2; ++bj) { const float* pb = bias + bj * HALF + wc * 32 + 8 * fq; bb[bj][0] = *(const f32x4*)pb; bb[bj][1] = *(const f32x4*)(pb + 4); }
               EPI_FOREACH({ *(u32x4*)(base + (size_t)row * ld + c0 + ct) = pack8(act4(v0 + bb[bj][0], 2), act4(v1 + bb[bj][1], 2)); }) }
    }
};
struct Hook3 {
    static constexpr int T = 16;
    const bf16_t *GMP, *GMM;
    __device__ __forceinline__ void operator()(Acc& acc, const Unit& u, int wr, int wc, int fr, int fq) const {
        unsigned off = ((unsigned)(u.pm * BM + wr * 64 + fr) * 1024u + (unsigned)(u.pn * 256 + wc * 32 + 8 * fq)) * 2u;
#pragma unroll
        for (int ai = 0; ai < 2; ++ai)
#pragma unroll
            for (int mp = 0; mp < 2; ++mp) {
                asm volatile("" : "+v"(off) :: "memory");
                u32x4 gp[2][2], gm[2][2];
#pragma unroll
                for (int mm = 0; mm < 2; ++mm)
#pragma unroll
                    for (int bj = 0; bj < 2; ++bj) { gp[mm][bj] = *(const u32x4*)((const char*)GMP + off + mm * 32768 + bj * 256); gm[mm][bj] = *(const u32x4*)((const char*)GMM + off + mm * 32768 + bj * 256); }
#pragma unroll
                for (int mm = 0; mm < 2; ++mm)
#pragma unroll
                    for (int bj = 0; bj < 2; ++bj) { const int m = mp * 2 + mm; f32x4 p0, p1, q0, q1; unpack8(gp[mm][bj], p0, p1); unpack8(gm[mm][bj], q0, q1);
#pragma unroll
                        for (int j = 0; j < 4; ++j) { acc[ai][bj][m][0][j] *= p0[j] * __builtin_amdgcn_rcpf(q0[j]); acc[ai][bj][m][1][j] *= p1[j] * __builtin_amdgcn_rcpf(q1[j]); } }
                off += (mp == 1 ? 96u : 32u) * 2048u;
            }
    }
};
struct Epi3 {
    const bf16_t* GMM; bf16_t* Z;
    __device__ __forceinline__ void operator()(const Acc& acc, const Unit& u, int wr, int wc, int fr, int fq) const {
        u32x4 gt[2][4][2];
#pragma unroll
        for (int ai = 0; ai < 2; ++ai)
#pragma unroll
            for (int m = 0; m < 4; ++m)
#pragma unroll
                for (int bj = 0; bj < 2; ++bj) gt[ai][m][bj] = *(const u32x4*)(GMM + (size_t)(u.pm * BM + ai * HALF + wr * 64 + m * 16 + fr) * 1024 + u.pn * 256 + bj * HALF + wc * 32 + 8 * fq);
        asm volatile("s_waitcnt vmcnt(0)" ::: "memory"); __builtin_amdgcn_sched_barrier(0);
#pragma unroll
        for (int ai = 0; ai < 2; ++ai)
#pragma unroll
            for (int m = 0; m < 4; ++m)
#pragma unroll
                for (int bj = 0; bj < 2; ++bj) { f32x4 g0, g1; unpack8(gt[ai][m][bj], g0, g1);
                    *(u32x4*)(Z + (size_t)(u.pm * BM + ai * HALF + wr * 64 + m * 16 + fr) * 1024 + u.pn * 256 + bj * HALF + wc * 32 + 8 * fq) = pack8(acc[ai][bj][m][0] * g0, acc[ai][bj][m][1] * g1); }
    }
};
struct Epi4 {
    const float* ada; bf16_t* GY;
    __device__ __forceinline__ void operator()(const Acc& acc, const Unit& u, int wr, int wc, int fr, int fq) const {
        const float* gate = ada + ((u.pm * BM) / S) * 3072 + 2048;
        f32x4 gg[2][2];
#pragma unroll
        for (int bj = 0; bj < 2; ++bj) { const float* pg = gate + u.pn * 256 + bj * HALF + wc * 32 + 8 * fq; gg[bj][0] = *(const f32x4*)pg; gg[bj][1] = *(const f32x4*)(pg + 4); }
        EPI_FOREACH({ const int col = u.pn * 256 + ct; const size_t o = (size_t)row * 1024 + col;
            *(u32x4*)(GY + o) = pack8(gg[bj][0] * v0, gg[bj][1] * v1); })
    }
};
}

__device__ __forceinline__ void tr_item(const float* __restrict__ W, int ld, int N32, bf16_t* __restrict__ dst, int dst_ld, int dst_koff, int mode, const float* __restrict__ kscale,
                                        int item, LAS float* scr, int lane) {
    const int nb = item % N32, kb = item / N32, k0 = 64 * kb, n0 = 32 * nb, nl = lane & 31;
    int n = n0 + nl, col;
    if (mode == 0) col = n;
    else if (mode == 1) { n += 1024; col = n < C_GM ? n : (n < C_KV ? n + 192 : (n < C_KV + 192 ? n - C_KV + 2304 : -1)); }
    else if (mode == 2) col = (n >> 7) * 256 + 128 + (n & 127);
    else col = (n / 64) * 192 + 128 + (n % 64);
    float tv[32];
#pragma unroll
    for (int i = 0; i < 32; ++i) { const int kk = 2 * i + (lane >> 5), k = k0 + kk;
        const int ks = (mode == 2) ? ((k & ~15) + 8 * ((k & 7) >> 2) + 4 * ((k >> 3) & 1) + (k & 3)) : k;
        tv[i] = col >= 0 ? W[(size_t)ks * ld + col] * (kscale ? kscale[k] : 1.f) : 0.f; }
#pragma unroll
    for (int i = 0; i < 32; ++i) scr[(2 * i + (lane >> 5)) * 33 + nl] = tv[i];
    asm volatile("s_waitcnt lgkmcnt(0)" ::: "memory");
    const int c = lane & 7;
#pragma unroll
    for (int j = 0; j < 4; ++j) { const int nn = (lane >> 3) + 8 * j; const LAS float* sp = scr + (8 * c) * 33 + nn;
        const u32x4 o = cvt4_pk_bf16(sp[0 * 33], sp[1 * 33], sp[2 * 33], sp[3 * 33], sp[4 * 33], sp[5 * 33], sp[6 * 33], sp[7 * 33]);
        int ng = n0 + nn; size_t drow;
        if (mode == 1) drow = 1024 + ng; else if (mode == 3) drow = (size_t)(ng / 64) * 192 + 128 + (ng % 64); else drow = ng;
        *(u32x4*)(dst + drow * dst_ld + dst_koff + k0 + 8 * c) = o; }
    asm volatile("s_waitcnt lgkmcnt(0)" ::: "memory");
}
__device__ __forceinline__ void p0_prep(const Params& P, unsigned char* lds, LAS unsigned char* ldsl, const int wave) {
    unsigned char* ws = P.ws; float* fl = (float*)lds;
    const int lane = lane_id(), tid = wave * 64 + lane, bid = blockIdx.x, G = gridDim.x;
    float* ADA = (float*)(ws + WS_ADA);
    if (bid < 96) {
        float* sl = fl;
        float* red = fl + 17 * 1024;
        {
            f32x4 cv[9];
#pragma unroll
            for (int q = 0; q < 9; ++q) { const int i4 = tid + NTHREADS * q; const int r = i4 >> 8, k = (i4 & 255) * 4;
                cv[q] = (i4 < 17 * 256) ? *(const f32x4*)(r < 16 ? P.c + r * D + k : P.c_ctx + k) : (f32x4){0.f, 0.f, 0.f, 0.f}; }
#pragma unroll
            for (int q = 0; q < 9; ++q) { const int i4 = tid + NTHREADS * q;
                if (i4 < 17 * 256) { f32x4 o; for (int e = 0; e < 4; ++e) o[e] = siluf(cv[q][e]); *(f32x4*)(sl + i4 * 4) = o; } }
        }
        __syncthreads();
        const int j = bid * 32 + (lane & 31), kb = wave * 128 + (lane >> 5);
        float acc[17];
#pragma unroll
        for (int r = 0; r < 17; ++r) acc[r] = 0.f;
#pragma unroll 8
        for (int i = 0; i < 64; ++i) { const int k = kb + 2 * i; const float w = P.ada_w[(size_t)k * 3072 + j];
#pragma unroll
            for (int r = 0; r < 17; ++r) acc[r] += sl[r * 1024 + k] * w; }
#pragma unroll
        for (int r = 0; r < 17; ++r) { acc[r] = half_swap_sum(acc[r]); if (lane < 32) red[(wave * 17 + r) * 32 + lane] = acc[r]; }
        __syncthreads();
        for (int i = tid; i < 17 * 32; i += NTHREADS) { const int r = i >> 5, jj = i & 31; float s = 0.f;
            for (int w = 0; w < 8; ++w) s += red[(w * 17 + r) * 32 + jj];
            ADA[r * 3072 + bid * 32 + jj] = s + P.ada_b[bid * 32 + jj]; }
        asm volatile("s_waitcnt vmcnt(0)" ::: "memory"); __syncthreads();
        if (tid == 0) { __builtin_amdgcn_fence(__ATOMIC_RELEASE, "agent"); asm volatile("s_waitcnt vmcnt(0)" ::: "memory");
            __hip_atomic_fetch_add((unsigned*)(ws + WS_BAR) + ADA_CNT_WORD, 1u, __ATOMIC_RELAXED, __HIP_MEMORY_SCOPE_AGENT); }
    } else if (bid < 96 + 64) {
        const int it = bid - 96, h = it >> 2, k0 = (it & 3) * 64;
        float* As = fl;
        float* Bs = fl + 64 * 129;
        {
            f32x4 av[4], bv[8];
#pragma unroll
            for (int q = 0; q < 4; ++q) { const int i4 = tid + NTHREADS * q, kk = i4 >> 5, j = (i4 & 31) * 4; av[q] = *(const f32x4*)(P.w_qb + (size_t)(k0 + kk) * 3072 + h * 192 + j); }
#pragma unroll
            for (int q = 0; q < 8; ++q) { const int i4 = tid + NTHREADS * q, l = i4 >> 5, j = (i4 & 31) * 4; bv[q] = *(const f32x4*)(P.w_kvb + (size_t)l * 4096 + h * 256 + j); }
#pragma unroll
            for (int q = 0; q < 4; ++q) { const int i4 = tid + NTHREADS * q, kk = i4 >> 5, j = (i4 & 31) * 4; for (int e = 0; e < 4; ++e) As[kk * 129 + j + e] = av[q][e]; }
#pragma unroll
            for (int q = 0; q < 8; ++q) { const int i4 = tid + NTHREADS * q, l = i4 >> 5, j = (i4 & 31) * 4; for (int e = 0; e < 4; ++e) Bs[l * 129 + j + e] = bv[q][e]; }
        }
        __syncthreads();
        const int kk = tid & 63, lb = tid >> 6; const float qg = P.q_norm_g[k0 + kk];
#pragma unroll 1
        for (int i = 0; i < 16; ++i) { const int l = lb + 8 * i; float a = 0.f;
#pragma unroll 8
            for (int j = 0; j < 128; ++j) a += As[kk * 129 + j] * Bs[l * 129 + j];
            ((bf16_t*)(ws + WS_WQT))[((size_t)h * 192 + l) * 256 + k0 + kk] = f2bf(a * qg); }
        __syncthreads();
    } else if (bid == 96 + 64) {
        float* rope = (float*)(ws + WS_ROPE);
        for (int i = tid; i < 64 * 16; i += NTHREADS) { const int pos = i >> 4, f = i & 15; const float a = (float)pos * powf(10000.f, -(float)f / 16.f); rope[i * 2] = cosf(a); rope[i * 2 + 1] = sinf(a); }
    }
    __syncthreads();
    {
        LAS float* scr = (LAS float*)(ldsl + wave * 8448);
        constexpr int I_WIN = ((N1 - 1024) / 32) * 16, I_PP = 32 * 16, I_PM = 32 * 32, I_OUT = 32 * 16, I_VB = 64 * 2, I_QR = 32 * 4;
        constexpr int NITEMS = I_WIN + I_PP + I_PM + I_OUT + I_VB + I_QR;
        for (int it = bid * NWAVES + wave; it < NITEMS; it += G * NWAVES) {
            int r = it;
            if (r < I_WIN) { tr_item(P.w_in, INW, (N1 - 1024) / 32, (bf16_t*)(ws + WS_WINT), 1024, 0, 1, nullptr, r, scr, lane); continue; } r -= I_WIN;
            if (r < I_PP) { tr_item(P.w_pp, 1024, 32, (bf16_t*)(ws + WS_WCAT), 3072, 0, 0, nullptr, r, scr, lane); continue; } r -= I_PP;
            if (r < I_PM) { tr_item(P.w_pm, 1024, 32, (bf16_t*)(ws + WS_WCAT), 3072, 1024, 0, nullptr, r, scr, lane); continue; } r -= I_PM;
            if (r < I_OUT) { tr_item(P.w_out, 1024, 32, (bf16_t*)(ws + WS_WOUT), 1024, 0, 0, nullptr, r, scr, lane); continue; } r -= I_OUT;
            if (r < I_VB) { tr_item(P.w_kvb, 4096, 64, (bf16_t*)(ws + WS_WVBT), 128, 0, 2, nullptr, r, scr, lane); continue; } r -= I_VB;
            tr_item(P.w_qb, 3072, 32, (bf16_t*)(ws + WS_WQT), 256, 0, 3, P.q_norm_g, r, scr, lane);
        }
        __syncthreads();
    }
    for (int it = (bid + G - 160 % G) % G; it < 256; it += G) {
        const int g = it >> 6, k0 = ((it >> 2) & 15) * 64, d0 = (it & 3) * 64;
        float* As = fl;
        float* Bs = fl + 64 * 257;
        {
            f32x4 av[8], bv[8];
#pragma unroll
            for (int q = 0; q < 8; ++q) { const int i4 = tid + NTHREADS * q, kk = i4 >> 6, c = (i4 & 63) * 4; av[q] = *(const f32x4*)(P.w_in + (size_t)(k0 + kk) * INW + g * 256 + c); }
#pragma unroll
            for (int q = 0; q < 8; ++q) { const int i4 = tid + NTHREADS * q, c = i4 >> 4, d = (i4 & 15) * 4; bv[q] = *(const f32x4*)(P.w_pool + ((size_t)g * 256 + c) * 256 + d0 + d); }
#pragma unroll
            for (int q = 0; q < 8; ++q) { const int i4 = tid + NTHREADS * q, kk = i4 >> 6, c = (i4 & 63) * 4; for (int e = 0; e < 4; ++e) As[kk * 257 + c + e] = av[q][e]; }
#pragma unroll
            for (int q = 0; q < 8; ++q) { const int i4 = tid + NTHREADS * q, c = i4 >> 4, d = (i4 & 15) * 4; *(f32x4*)(Bs + c * 64 + d) = bv[q]; }
        }
        __syncthreads();
        const int kk = tid & 63, db = tid >> 6;
        f32x4 a0 = {0.f, 0.f, 0.f, 0.f}, a1 = {0.f, 0.f, 0.f, 0.f};
#pragma unroll 8
        for (int c = 0; c < 256; ++c) { const float av = As[kk * 257 + c]; const f32x4 b0 = *(const f32x4*)(Bs + c * 64 + 8 * db), b1 = *(const f32x4*)(Bs + c * 64 + 8 * db + 4);
            a0 += b0 * av; a1 += b1 * av; }
#pragma unroll
        for (int i = 0; i < 4; ++i) { ((bf16_t*)(ws + WS_WINT))[((size_t)g * 256 + d0 + 8 * db + i) * 1024 + k0 + kk] = f2bf(a0[i]);
                                      ((bf16_t*)(ws + WS_WINT))[((size_t)g * 256 + d0 + 8 * db + 4 + i) * 1024 + k0 + kk] = f2bf(a1[i]); }
        __syncthreads();
    }
}

__device__ __forceinline__ void h_rows(const Params& P, const int lane, const int first, const int step, const int last  ) {
    const float* ADA = (const float*)(P.ws + WS_ADA); bf16_t* H = (bf16_t*)P.out;
    f32x4 g[4];
#pragma unroll
    for (int j = 0; j < 4; ++j) g[j] = *(const f32x4*)(P.norm_g + 256 * j + 4 * lane);
    for (int row0 = 4 * first; row0 < last; row0 += 4 * step) {
        f32x4 v[4][4], ma[4], mb[4]; float ss[4];
        const float* sh = ADA + (row0 < M ? row0 / S : 16) * 3072, *sc = sh + 1024;
#pragma unroll
        for (int u = 0; u < 4; ++u) { const int row = row0 + u; const float* src = row < M ? P.x + (size_t)row * D : P.ctx + (size_t)(row - M) * D; ss[u] = 0.f;
#pragma unroll
            for (int j = 0; j < 4; ++j) { v[u][j] = *(const f32x4*)(src + 256 * j + 4 * lane); ss[u] += v[u][j][0] * v[u][j][0] + v[u][j][1] * v[u][j][1] + v[u][j][2] * v[u][j][2] + v[u][j][3] * v[u][j][3]; } }
#pragma unroll
        for (int j = 0; j < 4; ++j) { const int c0 = 256 * j + 4 * lane; ma[j] = g[j] * (*(const f32x4*)(sc + c0) + 1.f); mb[j] = *(const f32x4*)(sh + c0); }
#pragma unroll
        for (int u = 0; u < 4; ++u) { const int row = row0 + u;
            const float rinv = rsqrtf(wave_sum(ss[u]) * (1.f / D) + EPS);
#pragma unroll
            for (int j = 0; j < 4; ++j) { const int c0 = 256 * j + 4 * lane;
                const f32x4 o = v[u][j] * rinv * ma[j] + mb[j]; const u32x2 w = cvt2_pk_bf16(o[0], o[1], o[2], o[3]);
                *(u32x2*)(H + (size_t)row * D + c0) = w; } }
    }
}
__device__ __forceinline__ void p1_h(const Params& P, const int wave) {
    const int lane = lane_id();
    {
        if (wave == 0) { unsigned* cnt = (unsigned*)(P.ws + WS_BAR) + ADA_CNT_WORD; unsigned sp = 0;
            while ((unsigned)__builtin_amdgcn_readfirstlane((int)__hip_atomic_load(cnt, __ATOMIC_RELAXED, __HIP_MEMORY_SCOPE_AGENT)) < 96u) { __builtin_amdgcn_s_sleep(2); if (++sp > (1u << 22)) break; }
            __builtin_amdgcn_fence(__ATOMIC_ACQUIRE, "agent"); asm volatile("s_waitcnt vmcnt(0)" ::: "memory"); }
        __syncthreads();
    }
    h_rows(P, lane, blockIdx.x * NWAVES + wave, gridDim.x * NWAVES, MT);
}

__device__ __forceinline__ f32x4 ld4bf(const bf16_t* p) { const u32x2 w = *(const u32x2*)p; return (f32x4){bflo(w.x), bfhi(w.x), bflo(w.y), bfhi(w.y)}; }
template <int HW>
__device__ __forceinline__ void pool_half(const char* UWc, const char* SGPc, char* CATc, unsigned uo  , unsigned co  , const int tl  , const f32x4 ps) {
    constexpr int NR = 16 + 2 * HW;
    asm volatile("" : "+v"(uo), "+v"(co));
    u32x2 ur[NR], sr[16];
#pragma unroll
    for (int r = 0; r < NR; ++r) { const int row = tl - HW + r; const bool ok = (unsigned)row < (unsigned)S; ur[r] = *(const u32x2*)(UWc + (uo + (unsigned)((ok ? r - HW : 0) * 2048))); if (!ok) ur[r] = (u32x2){0u, 0u}; }
#pragma unroll
    for (int k = 0; k < 16; ++k) sr[k] = *(const u32x2*)(SGPc + (uo + (unsigned)(k * 2048)));
    auto f4 = [](const u32x2 w) { return (f32x4){bflo(w.x), bfhi(w.x), bflo(w.y), bfhi(w.y)}; };
    f32x4 sum = {0.f, 0.f, 0.f, 0.f};
#pragma unroll
    for (int r = 0; r < 2 * HW; ++r) sum += f4(ur[r]);
#pragma unroll
    for (int k = 0; k < 16; ++k) {
        const int t = tl + k, lo = max(t - HW, 0), hi = min(t + HW, S);
        const f32x4 o = (sum * (1.f / (float)(hi - lo)) - f4(ur[k + HW])) * ps * f4(sr[k]);
        const u32x2 w = cvt2_pk_bf16(o[0], o[1], o[2], o[3]);
        *(u32x2*)(CATc + (co + (unsigned)(k * 6144))) = w;
        sum += f4(ur[k + 2 * HW]) - f4(ur[k]);
    }
}
template <class Epi>
__device__ __forceinline__ void p3_thin(const Params& P, const int wave, LAS unsigned char* ldsl, const bool split, const Epi& e1) {
    const int lane = lane_id(), bid = blockIdx.x, G = gridDim.x;
    const bool ctxwg = split && bid < MC / 256;
    const int nthin = split ? G - MC / 256 : G, gw = ((split ? bid - MC / 256 : bid) * NWAVES + wave), NGW = nthin * NWAVES;
    const float* KVA = (const float*)((const unsigned char*)P.out + OUT_KVA); const float* rope = (const float*)(P.ws + WS_ROPE); bf16_t* KC = (bf16_t*)(P.ws + WS_KC);
    if (ctxwg) {
        {
            const int tid_ = wave * 64 + lane;
            const char* pa = (const char*)P.out + (size_t)(M + bid * 256) * 2048; const char* pb = (const char*)(P.ws + WS_WINT) + (size_t)C_KV * 2048;
#pragma unroll 1
            for (int i = 0; i < 8; ++i) {
                f32x4 t[16];
#pragma unroll
                for (int q = 0; q < 8; ++q) { t[q] = *(const f32x4*)(pa + (size_t)(i * 8 + q) * 8192 + tid_ * 16); t[8 + q] = *(const f32x4*)(pb + (size_t)(i * 8 + q) * 8192 + tid_ * 16); }
#pragma unroll
                for (int q = 0; q < 16; ++q) asm volatile("" :: "v"(t[q]));
            }
        }
        pg8::Gemm g{(const bf16_t*)P.out, (const bf16_t*)(P.ws + WS_WINT), 1024, 1024, 1024, 0};
        pg8::OneUnit ou{{M / 256 + bid, N1 / 256 - 1}};
        pg8::gemm_phase(ldsl, g, ou, e1, wave);
        asm volatile("s_waitcnt vmcnt(0)" ::: "memory"); __syncthreads();
        __builtin_amdgcn_fence(__ATOMIC_ACQUIRE, "agent"); asm volatile("s_waitcnt vmcnt(0)" ::: "memory"); __syncthreads();
    }
    const int l16 = lane & 15;
    const f32x4 g0 = *(const f32x4*)(P.kv_norm_g + 8 * l16), g1 = *(const f32x4*)(P.kv_norm_g + 8 * l16 + 4);
    const int kp_first = ctxwg ? (M + bid * 256) / 4 + wave : (split ? (gw < 0 ? 0 : gw) : gw), kp_step = ctxwg ? NWAVES : NGW, kp_last = ctxwg ? (M + bid * 256 + 256) / 4 : (split ? M / 4 : MT / 4);
    for (int it = kp_first; it < kp_last; it += kp_step) {
        const int t = it * 4 + (lane >> 4); const bool isx = t < M;
        const int b = isx ? t / S : (t - M) / CTX, pos = isx ? t % S : (t - M) % CTX, key = isx ? pos : S + pos;
        const float* src = KVA + (size_t)t * 256;
        const f32x4 c0 = *(const f32x4*)(src + 8 * l16), c1 = *(const f32x4*)(src + 8 * l16 + 4); f32x4 kr = *(const f32x4*)(src + 128 + 4 * l16);
        const int w8 = l16 & 7, pp = (l16 >= 8) ? (pos & 63) : (pos >> 6), i0 = 4 * (w8 & 3);
        f32x4 t0 = {0.f, 0.f, 0.f, 0.f}, t1 = t0;
        if (isx) { t0 = *(const f32x4*)(rope + (pp * 16 + i0) * 2); t1 = *(const f32x4*)(rope + (pp * 16 + i0) * 2 + 4); }
        float ss = c0[0] * c0[0] + c0[1] * c0[1] + c0[2] * c0[2] + c0[3] * c0[3] + c1[0] * c1[0] + c1[1] * c1[1] + c1[2] * c1[2] + c1[3] * c1[3];
        ss += swz_xor<1>(ss); ss += swz_xor<2>(ss); ss += swz_xor<4>(ss); ss += swz_xor<8>(ss);
        const float rinv = rsqrtf(ss * (1.f / KVL) + EPS);
        bf16_t* dst = KC + ((size_t)b * NKEY + key) * QKD;
        *(u32x4*)(dst + 8 * l16) = pg8::pack8(c0 * rinv * g0, c1 * rinv * g1);
        const f32x4 other = {swz_xor<4>(kr[0]), swz_xor<4>(kr[1]), swz_xor<4>(kr[2]), swz_xor<4>(kr[3])};
        if (isx) {
            const f32x4 cs = {t0[0], t0[2], t1[0], t1[2]}, sn = {t0[1], t0[3], t1[1], t1[3]};
            kr = (w8 < 4) ? kr * cs - other * sn : kr * cs + other * sn;
        }
        const u32x2 o = cvt2_pk_bf16(kr[0], kr[1], kr[2], kr[3]);
        *(u32x2*)(dst + 128 + 4 * l16) = o;
    }
    const bf16_t* UW = (const bf16_t*)(P.ws + WS_U); const bf16_t* SGP = (const bf16_t*)(P.ws + WS_SGP); bf16_t* CAT = (bf16_t*)(P.ws + WS_CAT);
    for (int it = ctxwg ? NB * 64 * 4 : gw; it < NB * 64 * 4; it += NGW) {
        const int g = it & 3, ch = (it >> 2) & 63, b = it >> 8, t0 = ch * 32, col = g * 256 + 4 * lane;
        const f32x4 ps = *(const f32x4*)(P.pool_scale + col);
#pragma unroll 1
        for (int th = t0; th < t0 + 32; th += 16) {
            const unsigned uo = (unsigned)(((b * S + th) * 1024 + col) * 2), co = (unsigned)(((size_t)(b * S + th) * 3072 + col) * 2);
            if (g == 0) pool_half<1>((const char*)UW, (const char*)SGP, (char*)CAT, uo, co, th, ps); else if (g == 1) pool_half<2>((const char*)UW, (const char*)SGP, (char*)CAT, uo, co, th, ps);
            else if (g == 2) pool_half<4>((const char*)UW, (const char*)SGP, (char*)CAT, uo, co, th, ps); else pool_half<8>((const char*)UW, (const char*)SGP, (char*)CAT, uo, co, th, ps);
        }
    }
}

namespace att {
using f32x16 = __attribute__((ext_vector_type(16))) float;
using s16x4  = __attribute__((ext_vector_type(4))) short;
constexpr float SCALE = 0.07216878364870322f;
constexpr float THR = 8.f;
constexpr int KVBLK = 64, NT = NKEY / KVBLK;
constexpr int WPITCH = 528, VPITCH = 272;
constexpr int KROW = 384;
constexpr int SHM_V = KVBLK * 128 * 2, SHM_K = KVBLK * KROW, V_OFF = 0, K_OFF = 3 * SHM_V;
static_assert(NT % 2 == 0 && K_OFF + 2 * SHM_K <= 131072 && 192 * WPITCH <= 131072, "attention LDS map");
#define SBAR() __builtin_amdgcn_sched_barrier(0)
__device__ __forceinline__ int crow(int r, int hi) { return (r & 3) + 8 * (r >> 2) + 4 * hi; }
__device__ __forceinline__ bf16x8 pack8r(const f32x16& a, int base) {
    u32x4 w = cvt4_pk_bf16(a[base + 0], a[base + 1], a[base + 2], a[base + 3], a[base + 4], a[base + 5], a[base + 6], a[base + 7]);
    return *reinterpret_cast<bf16x8*>(&w);
}
constexpr float CL2 = SCALE * 1.4426950408889634f;
#define PK4(P, BASE, OUT) do { const u32x4 c_ = cvt4_pk_bf16(P[BASE + 0], P[BASE + 1], P[BASE + 2], P[BASE + 3], P[BASE + 4], P[BASE + 5], P[BASE + 6], P[BASE + 7]); \
    const unsigned a0_ = c_.x, a1_ = c_.y, b0_ = c_.z, b1_ = c_.w;                                                                  \
    auto r0_ = __builtin_amdgcn_permlane32_swap(a0_, b0_, false, false); auto r1_ = __builtin_amdgcn_permlane32_swap(a1_, b1_, false, false); \
    u32x4 w_ = {r0_[0], r1_[0], r0_[1], r1_[1]}; OUT = *reinterpret_cast<bf16x8*>(&w_); } while (0)
template <int OFF> __device__ __forceinline__ bf16x8 k_read(int ka) { bf16x8 r; asm volatile("ds_read_b128 %0, %1 offset:%2" : "=&v"(r) : "v"(ka), "i"(OFF) : "memory"); return r; }
#define LGKM(n) asm volatile("s_waitcnt lgkmcnt(" #n ")" ::: "memory")
template <int KB, bool FIN> __device__ __forceinline__ void qkt_fin(f32x16& n0, f32x16& n1, const int (&ka)[4], const bf16x8* qr,
                                                                    f32x16& f0, f32x16& f1, const float al, float& l_reg, bf16x8& pa0, bf16x8& pa1, bf16x8& pa2, bf16x8& pa3) {
    n0 = f32x16{}; n1 = f32x16{};
    constexpr int H1 = 32 * KROW;
    float ps0 = 0.f, ps1 = 0.f;
#define QSTEP(D, A0, A1, NW) LGKM(NW); SBAR(); n0 = __builtin_amdgcn_mfma_f32_32x32x16_bf16(A0, qr[D], n0, 0, 0, 0); n1 = __builtin_amdgcn_mfma_f32_32x32x16_bf16(A1, qr[D], n1, 0, 0, 0);
#define QLOAD(D, A0, A1) A0 = k_read<KB + ((D) >> 2) * 128>(ka[(D) & 3]); A1 = k_read<KB + H1 + ((D) >> 2) * 128>(ka[(D) & 3]);
#define FEXP(K) if constexpr (FIN) { _Pragma("unroll") for (int r_ = 4 * (K); r_ < 4 * (K) + 4; ++r_) f1[r_] = __builtin_amdgcn_exp2f(f1[r_]); }
    bf16x8 a0, a1, b0, b1, c0, c1;
    QLOAD(0, a0, a1) QLOAD(1, b0, b1) QLOAD(2, c0, c1)
    QSTEP(0, a0, a1, 4) QLOAD(3, a0, a1) FEXP(0)
    QSTEP(1, b0, b1, 4) QLOAD(4, b0, b1) FEXP(1)
    QSTEP(2, c0, c1, 4) QLOAD(5, c0, c1) FEXP(2)
    QSTEP(3, a0, a1, 4) QLOAD(6, a0, a1) FEXP(3)
    QSTEP(4, b0, b1, 4) QLOAD(7, b0, b1)
    if constexpr (FIN) {
#pragma unroll
        for (int r = 0; r < 16; ++r) ps0 += f0[r]; }
    QSTEP(5, c0, c1, 4) QLOAD(8, c0, c1)
    if constexpr (FIN) {
#pragma unroll
        for (int r = 0; r < 16; ++r) ps1 += f1[r]; }
    QSTEP(6, a0, a1, 4) QLOAD(9, a0, a1)
    if constexpr (FIN) { float ps = ps0 + ps1; ps = half_swap_sum(ps); l_reg = l_reg * al + ps; }
    QSTEP(7, b0, b1, 4) QLOAD(10, b0, b1)
    if constexpr (FIN) { PK4(f0, 0, pa0); }
    QSTEP(8, c0, c1, 4) QLOAD(11, c0, c1)
    if constexpr (FIN) { PK4(f0, 8, pa1); }
    QSTEP(9, a0, a1, 4)
    if constexpr (FIN) { PK4(f1, 0, pa2); }
    QSTEP(10, b0, b1, 2)
    if constexpr (FIN) { PK4(f1, 8, pa3); }
    QSTEP(11, c0, c1, 0)
    SBAR();
#undef QSTEP
#undef QLOAD
#undef FEXP
}
__device__ __forceinline__ void finishSM(f32x16& f0, f32x16& f1, const float al, float& l_reg, bf16x8& pa0, bf16x8& pa1, bf16x8& pa2, bf16x8& pa3) {
#pragma unroll
    for (int r = 0; r < 16; ++r) f1[r] = __builtin_amdgcn_exp2f(f1[r]);
    float ps = 0.f;
#pragma unroll
    for (int r = 0; r < 16; ++r) ps += f0[r];
#pragma unroll
    for (int r = 0; r < 16; ++r) ps += f1[r];
    ps = half_swap_sum(ps); l_reg = l_reg * al + ps;
    PK4(f0, 0, pa0); PK4(f0, 8, pa1); PK4(f1, 0, pa2); PK4(f1, 8, pa3);
}
__device__ __forceinline__ float sm_rowmax(const f32x16& s0, const f32x16& s1) {
    float pmax = s0[0];
#pragma unroll
    for (int r = 1; r < 16; ++r) pmax = fmaxf(pmax, s0[r]);
#pragma unroll
    for (int r = 0; r < 16; ++r) pmax = fmaxf(pmax, s1[r]);
    return half_swap_max(pmax);
}
__device__ __forceinline__ void sm_decide(const float pmax, float& m_reg, float& mnC, float& alpha) {
    const bool keep = __all(pmax - m_reg <= THR / SCALE);
    const float mn = keep ? m_reg : fmaxf(m_reg, pmax);
    alpha = keep ? 1.f : __builtin_amdgcn_exp2f((m_reg - mn) * CL2);
    m_reg = mn; mnC = -mn * CL2;
}
__device__ __forceinline__ void partialSM(f32x16& s0, f32x16& s1, float& m_reg, float& alpha) {
    float mnC; sm_decide(sm_rowmax(s0, s1), m_reg, mnC, alpha);
#pragma unroll
    for (int r = 0; r < 16; ++r) s0[r] = fmaf(s0[r], CL2, mnC);
#pragma unroll
    for (int r = 0; r < 16; ++r) s1[r] = fmaf(s1[r], CL2, mnC);
#pragma unroll
    for (int r = 0; r < 16; ++r) s0[r] = __builtin_amdgcn_exp2f(s0[r]);
}
__device__ __forceinline__ int v_st(int k, int c) { const int kk = (k & ~0xC) | ((k & 4) << 1) | ((k & 8) >> 1); return ((kk >> 3) * 4 + (c >> 5)) * 512 + ((kk & 7) * 32 + (c & 31)) * 2; }
__device__ __forceinline__ int v_rd_base(int lane) { return ((lane & 3) << 3) | (((lane >> 2) & 3) << 6) | (((lane >> 4) & 1) << 5) | (((lane >> 5) & 1) << 8); }
constexpr int v_rd_off(int d0, int ks, int half) { return d0 * 512 + ks * 4096 + half * 2048; }
template <int OFF> __device__ __forceinline__ s16x4 tr_read(int vb) {
    s16x4 r; asm volatile("ds_read_b64_tr_b16 %0, %1 offset:%2" : "=&v"(r) : "v"(vb), "i"(OFF) : "memory"); return r;
}
struct VF { s16x4 l0, h0, l1, h1, l2, h2, l3, h3; };
template <int VB, int D0> __device__ __forceinline__ void v_load(VF& f, int vb) {
    f.l0 = tr_read<VB + v_rd_off(D0, 0, 0)>(vb); f.h0 = tr_read<VB + v_rd_off(D0, 0, 1)>(vb); f.l1 = tr_read<VB + v_rd_off(D0, 1, 0)>(vb); f.h1 = tr_read<VB + v_rd_off(D0, 1, 1)>(vb);
    f.l2 = tr_read<VB + v_rd_off(D0, 2, 0)>(vb); f.h2 = tr_read<VB + v_rd_off(D0, 2, 1)>(vb); f.l3 = tr_read<VB + v_rd_off(D0, 3, 0)>(vb); f.h3 = tr_read<VB + v_rd_off(D0, 3, 1)>(vb);
}
__device__ __forceinline__ void v_mma(f32x16& od, const VF& f, bf16x8 pa0, bf16x8 pa1, bf16x8 pa2, bf16x8 pa3) {
#define PK(L, H) (bf16x8){L[0], L[1], L[2], L[3], H[0], H[1], H[2], H[3]}
    od = __builtin_amdgcn_mfma_f32_32x32x16_bf16(PK(f.l0, f.h0), pa0, od, 0, 0, 0);
    od = __builtin_amdgcn_mfma_f32_32x32x16_bf16(PK(f.l1, f.h1), pa1, od, 0, 0, 0);
    od = __builtin_amdgcn_mfma_f32_32x32x16_bf16(PK(f.l2, f.h2), pa2, od, 0, 0, 0);
    od = __builtin_amdgcn_mfma_f32_32x32x16_bf16(PK(f.l3, f.h3), pa3, od, 0, 0, 0);
#undef PK
}
template <int VB, bool PART> __device__ __forceinline__ void pv_part(f32x16* o, int vb, bf16x8 pa0, bf16x8 pa1, bf16x8 pa2, bf16x8 pa3,
                                                                     f32x16& s0, f32x16& s1, float& m_reg, float& alpha) {
    VF fa, fb; float pmax = 0.f, mnC = 0.f;
    v_load<VB, 0>(fa, vb); v_load<VB, 1>(fb, vb);
    LGKM(8); SBAR(); v_mma(o[0], fa, pa0, pa1, pa2, pa3); v_load<VB, 2>(fa, vb);
    if constexpr (PART) pmax = sm_rowmax(s0, s1);
    LGKM(8); SBAR(); v_mma(o[1], fb, pa0, pa1, pa2, pa3); v_load<VB, 3>(fb, vb);
    if constexpr (PART) { sm_decide(pmax, m_reg, mnC, alpha);
#pragma unroll
        for (int r = 0; r < 16; ++r) s0[r] = fmaf(s0[r], CL2, mnC); }
    LGKM(8); SBAR(); v_mma(o[2], fa, pa0, pa1, pa2, pa3);
    if constexpr (PART) {
#pragma unroll
        for (int r = 0; r < 16; ++r) s1[r] = fmaf(s1[r], CL2, mnC);
#pragma unroll
        for (int r = 0; r < 8; ++r) s0[r] = __builtin_amdgcn_exp2f(s0[r]); }
    LGKM(0); SBAR(); v_mma(o[3], fb, pa0, pa1, pa2, pa3);
    if constexpr (PART) {
#pragma unroll
        for (int r = 8; r < 16; ++r) s0[r] = __builtin_amdgcn_exp2f(s0[r]); }
    SBAR();
}

__device__ __forceinline__ void attn_unit(const bf16_t* __restrict__ QAu, const bf16_t* __restrict__ WqTh, const bf16_t* __restrict__ Kb, const bf16_t* __restrict__ WvbPh,
                                          const float* __restrict__ rope, bf16_t* __restrict__ A2u, const int pos0, LAS unsigned char* lds, const int wid) {
    const int lane = lane_id(), tid = wid * 64 + lane, r32 = lane & 31, hi = lane >> 5;
    LAS unsigned char* V_lds = lds + V_OFF; LAS unsigned char* K_lds = lds + K_OFF;
    int ka[4];
    { const int sw = (r32 >> 1) & 7;
#pragma unroll
      for (int q = 0; q < 4; ++q) ka[q] = (int)(unsigned)(uintptr_t)K_lds + r32 * KROW + (((2 * q + hi) ^ sw) << 4); }
    const int vb0 = (int)(unsigned)(uintptr_t)V_lds + v_rd_base(lane);
    int ko[3], vo[2];
#pragma unroll
    for (int i = 0; i < 3; ++i) { const int L = (wid * 3 + i) * 64 + lane, row = L / 24, cp = L % 24, c = (cp & ~7) | ((cp & 7) ^ ((row >> 1) & 7)); ko[i] = row * KROW + c * 16; }
#pragma unroll
    for (int i = 0; i < 2; ++i) { const int B = ((wid * 2 + i) * 64 + lane) * 16, sub = B >> 9, w = (B & 511) >> 1, kk = (sub >> 2) * 8 + (w >> 5);
        const int k = (kk & ~0xC) | ((kk & 4) << 1) | ((kk & 8) >> 1), col = (sub & 3) * 32 + (w & 31); vo[i] = k * KROW + col * 2; }
    const __amdgpu_buffer_rsrc_t krs = __builtin_amdgcn_make_buffer_rsrc((void*)Kb, 0, NKEY * QKD * 2, 0x00020000);
#define DMA(tile, kb, voff) do { const int so_ = (tile) * (KVBLK * KROW);                                                                                          \
        _Pragma("unroll") for (int i_ = 0; i_ < 3; ++i_) __builtin_amdgcn_raw_ptr_buffer_load_lds(krs, (LAS void*)(K_lds + (kb) * SHM_K + (wid * 3 + i_) * 1024), 16, ko[i_], so_, 0, 0); \
        _Pragma("unroll") for (int i_ = 0; i_ < 2; ++i_) __builtin_amdgcn_raw_ptr_buffer_load_lds(krs, (LAS void*)(V_lds + (voff) + (wid * 2 + i_) * 1024), 16, vo[i_], so_, 0, 0); } while (0)
    bf16x8 qr[12];
    { AT_BEGIN(2)
        bf16x8 qb[16]; float ss = 0.f;
        const bf16_t* qrow = QAu + (size_t)wid * 8192 + r32 * 16 + hi * 8;
#pragma unroll
        for (int kk = 0; kk < 16; ++kk) qb[kk] = *(const bf16x8*)(qrow + kk * 512);
#pragma unroll
        for (int kk = 0; kk < 16; ++kk)
#pragma unroll
            for (int j = 0; j < 8; ++j) { const float v = bf2f((bf16_t)qb[kk][j]); ss += v * v; }
        ss = half_swap_sum(ss);
        const float rinv = rsqrtf(ss * (1.f / QL) + EPS);
        const int rsw = (r32 & ~0xC) | ((r32 & 4) << 1) | ((r32 & 8) >> 1);
        const int pos = pos0 + wid * 32 + r32;
        unsigned t16 = (unsigned)tid * 16u; asm volatile("" : "+v"(t16));
        const int wdst = (int)(t16 >> 9) * WPITCH + (int)(t16 & 511u);
        {
            bf16x8 wv[12];
#pragma unroll
            for (int i = 0; i < 12; ++i) wv[i] = *(const bf16x8*)((const char*)WqTh + i * 8192 + t16);
#pragma unroll
            for (int i = 0; i < 12; ++i) *(LAS bf16x8*)(lds + i * 16 * WPITCH + wdst) = wv[i];
        }
        __syncthreads();
        const LAS unsigned char* wl = lds + rsw * WPITCH + hi * 16;
        f32x16 qacc[6];
#pragma unroll
        for (int t = 0; t < 6; ++t) {
            qacc[t] = f32x16{};
#pragma unroll
            for (int kk = 0; kk < 16; ++kk) { const bf16x8 a = *(const LAS bf16x8*)(wl + t * 32 * WPITCH + kk * 32); qacc[t] = __builtin_amdgcn_mfma_f32_32x32x16_bf16(a, qb[kk], qacc[t], 0, 0, 0); }
        }
        asm volatile("s_waitcnt lgkmcnt(0)" ::: "memory"); __syncthreads();
        DMA(0, 0, 0);
#pragma unroll
        for (int t = 0; t < 6; ++t) {
            f32x16 acc = qacc[t];
#pragma unroll
            for (int r = 0; r < 16; ++r) acc[r] *= rinv;
            if (t >= 4) {
                const int pp = (t == 4) ? (pos >> 6) : (pos & 63);
#pragma unroll
                for (int r = 0; r < 8; ++r) { const float2 cs = *(const float2*)(rope + (pp * 16 + 8 * hi + r) * 2);
                    const float x1 = acc[r], x2 = acc[r + 8]; acc[r] = x1 * cs.x - x2 * cs.y; acc[r + 8] = x2 * cs.x + x1 * cs.y; }
            }
            qr[2 * t] = pack8r(acc, 0); qr[2 * t + 1] = pack8r(acc, 8);
        }
      AT_END(2)
    }
#define RESC(a) do { if (__any((a) < 1.f)) { _Pragma("unroll") for (int d = 0; d < 4; ++d) _Pragma("unroll") for (int r = 0; r < 16; ++r) o[d][r] *= (a); } } while (0)
    float m_reg = -1e30f, l_reg = 0.f; f32x16 o[4] = {};
    { AT_BEGIN(1)
    f32x16 pA0, pA1, pB0, pB1; float alA, alB; bf16x8 pa0, pa1, pa2, pa3;
#define VNEXT(R) ((R) == 2 * SHM_V ? 0 : (R) + SHM_V)
#define VWRITE(R) ((R) >= SHM_V ? (R) - SHM_V : (R) + 2 * SHM_V)
    __syncthreads();
    DMA(1, 1, SHM_V);
    qkt_fin<0, false>(pA0, pA1, ka, qr, pB0, pB1, 1.f, l_reg, pa0, pa1, pa2, pa3); partialSM(pA0, pA1, m_reg, alA);
    __syncthreads();
    int R = 0;
    for (int j = 1; j + 1 < NT; j += 2) {
        DMA(j + 1, 0, VWRITE(R));
        SBAR(); qkt_fin<SHM_K, true>(pB0, pB1, ka, qr, pA0, pA1, alA, l_reg, pa0, pa1, pa2, pa3);
        pv_part<0, true>(o, vb0 + R, pa0, pa1, pa2, pa3, pB0, pB1, m_reg, alB);
        RESC(alB); __syncthreads(); R = VNEXT(R);
        DMA(j + 2, 1, VWRITE(R));
        SBAR(); qkt_fin<0, true>(pA0, pA1, ka, qr, pB0, pB1, alB, l_reg, pa0, pa1, pa2, pa3);
        pv_part<0, true>(o, vb0 + R, pa0, pa1, pa2, pa3, pA0, pA1, m_reg, alA);
        RESC(alA); __syncthreads(); R = VNEXT(R);
    }
    SBAR(); qkt_fin<SHM_K, true>(pB0, pB1, ka, qr, pA0, pA1, alA, l_reg, pa0, pa1, pa2, pa3);
    pv_part<0, true>(o, vb0 + R, pa0, pa1, pa2, pa3, pB0, pB1, m_reg, alB);
    RESC(alB); R = VNEXT(R);
    finishSM(pB0, pB1, alB, l_reg, pa0, pa1, pa2, pa3); SBAR();
    pv_part<0, false>(o, vb0 + R, pa0, pa1, pa2, pa3, pB0, pB1, m_reg, alB);
    AT_END(1) }
#undef VNEXT
#undef VWRITE
#undef DMA
#undef RESC
    bf16_t* arow = A2u + (size_t)(wid * 32 + r32) * 3072 + 8 * hi;
    u32x4 gq[8];
#pragma unroll
    for (int i = 0; i < 8; ++i) gq[i] = *(const u32x4*)(arow + 16 * i);
    __syncthreads();
    {
        bf16x8 wv[4];
        unsigned t16 = (unsigned)tid * 16u; asm volatile("" : "+v"(t16));
        const int vdst = (int)(t16 >> 8) * VPITCH + (int)(t16 & 255u);
#pragma unroll
        for (int i = 0; i < 4; ++i) wv[i] = *(const bf16x8*)((const char*)WvbPh + i * 8192 + t16);
#pragma unroll
        for (int i = 0; i < 4; ++i) *(LAS bf16x8*)(lds + i * 32 * VPITCH + vdst) = wv[i];
    }
    const float rl = __builtin_amdgcn_rcpf(l_reg);
    bf16x8 ob[8];
#pragma unroll
    for (int d = 0; d < 4; ++d) {
#pragma unroll
        for (int r = 0; r < 16; ++r) o[d][r] *= rl;
        ob[2 * d] = pack8r(o[d], 0); ob[2 * d + 1] = pack8r(o[d], 8); }
    __syncthreads();
    const LAS unsigned char* vl = lds + r32 * VPITCH + hi * 16;
#pragma unroll
    for (int vt = 0; vt < 4; ++vt) {
        f32x16 at = {};
#pragma unroll
        for (int ks = 0; ks < 8; ++ks) { const bf16x8 a = *(const LAS bf16x8*)(vl + vt * 32 * VPITCH + ks * 32); at = __builtin_amdgcn_mfma_f32_32x32x16_bf16(a, ob[ks], at, 0, 0, 0); }
#pragma unroll
        for (int gp = 0; gp < 2; ++gp) { const u32x4 L = gq[vt * 2 + gp];
            auto q0 = __builtin_amdgcn_permlane32_swap(L.x, L.z, false, false); auto q1 = __builtin_amdgcn_permlane32_swap(L.y, L.w, false, false);
            const int r0 = 8 * gp;
            u32x2 a, b;
            { const u32x4 c_ = cvt4_pk_bf16(at[r0 + 0] * bflo(q0[0]), at[r0 + 1] * bfhi(q0[0]), at[r0 + 2] * bflo(q1[0]), at[r0 + 3] * bfhi(q1[0]),
                                             at[r0 + 4] * bflo(q0[1]), at[r0 + 5] * bfhi(q0[1]), at[r0 + 6] * bflo(q1[1]), at[r0 + 7] * bfhi(q1[1]));
              a.x = c_.x; a.y = c_.y; b.x = c_.z; b.y = c_.w; }
            auto s0 = __builtin_amdgcn_permlane32_swap(a.x, b.x, false, false); auto s1 = __builtin_amdgcn_permlane32_swap(a.y, b.y, false, false);
            *(u32x4*)(arow + 16 * (vt * 2 + gp)) = (u32x4){s0[0], s1[0], s0[1], s1[1]}; }
    }
    __syncthreads();
}
#undef SBAR
#undef LGKM
#undef PK4
}

__device__ __forceinline__ void p5_attn(const Params& P, LAS unsigned char* lds, const int wid) {
    const int G = gridDim.x, c = blockIdx.x;
    const bf16_t* QA = (const bf16_t*)(P.ws + WS_QA); const bf16_t* WqT = (const bf16_t*)(P.ws + WS_WQT); const bf16_t* KC = (const bf16_t*)(P.ws + WS_KC);
    const bf16_t* WvbP = (const bf16_t*)(P.ws + WS_WVBT); const float* rope = (const float*)(P.ws + WS_ROPE); bf16_t* A2 = (bf16_t*)(P.ws + WS_CAT);
    constexpr int NU = NB * NH * (S / 256);
    for (int i = 0; ; ++i) {
        const int L = i * G + c; if (L >= NU) break;
        int b, h, qt;
        if (G == 256) { const int x = c & 7, loc = (i & 3) * 32 + (c >> 3); b = 2 * x + (i >> 2); h = loc >> 3; qt = loc & 7; }
        else { b = L / (NH * 8); h = (L >> 3) % NH; qt = L & 7; }
        const int tok0 = b * S + qt * 256;
        att::attn_unit(QA + (size_t)tok0 * QL, WqT + (size_t)h * QKD * QL, KC + (size_t)b * NKEY * QKD, WvbP + (size_t)h * VD * KVL, rope,
                       A2 + (size_t)tok0 * 3072 + 1024 + h * VD, qt * 256, lds, wid);
    }
}

__device__ __forceinline__ void p8_final(const Params& P, const int wave) {
    const int lane = lane_id(), gw = blockIdx.x * NWAVES + wave, NGW = gridDim.x * NWAVES;
    const bf16_t* GY = (const bf16_t*)(P.ws + WS_U);
    f32x4 g[4];
#pragma unroll
    for (int j = 0; j < 4; ++j) g[j] = *(const f32x4*)(P.final_g + 256 * j + 4 * lane);
    for (int row0 = 4 * gw; row0 < M; row0 += 4 * NGW) {
        f32x4 v[4][4]; float ss[4];
#pragma unroll
        for (int u = 0; u < 4; ++u) { const int row = row0 + u; const float* px = P.x + (size_t)row * D; const bf16_t* pg = GY + (size_t)row * D; ss[u] = 0.f;
#pragma unroll
            for (int j = 0; j < 4; ++j) { v[u][j] = __builtin_nontemporal_load((const f32x4*)(px + 256 * j + 4 * lane)) + ld4bf(pg + 256 * j + 4 * lane);
                ss[u] += v[u][j][0] * v[u][j][0] + v[u][j][1] * v[u][j][1] + v[u][j][2] * v[u][j][2] + v[u][j][3] * v[u][j][3]; } }
#pragma unroll
        for (int u = 0; u < 4; ++u) { float* p = P.out + (size_t)(row0 + u) * D; const float rinv = rsqrtf(wave_sum(ss[u]) * (1.f / D) + EPS);
#pragma unroll
            for (int j = 0; j < 4; ++j) __builtin_nontemporal_store(v[u][j] * rinv * g[j], (f32x4*)(p + 256 * j + 4 * lane)); }
    }
}

#ifndef PROBE_MASK
#define PROBE_MASK 0
#endif
#ifndef PROBE_ATTN
#define PROBE_ATTN 0
#endif
#define PH_BEGIN(k) unsigned long long t0_##k = 0; if ((PROBE_MASK >> (k)) & 1) t0_##k = __builtin_amdgcn_s_memrealtime();
#define PH_END(k) if ((PROBE_MASK >> (k)) & 1) { const unsigned long long t1_ = __builtin_amdgcn_s_memrealtime(); while (__builtin_amdgcn_s_memrealtime() - t1_ < t1_ - t0_##k) __builtin_amdgcn_s_sleep(16); }
__global__ void __launch_bounds__(NTHREADS, 2) fwd_megakernel(Params P) {
    extern __shared__ __attribute__((aligned(16))) unsigned char lds[];
    cg::grid_group grid = cg::this_grid();
    LAS unsigned char* ldsl = (LAS unsigned char*)lds;
    unsigned char* ws = P.ws; const int G = gridDim.x, bid = blockIdx.x, wid = __builtin_amdgcn_readfirstlane(threadIdx.x >> 6);
    bf16_t* WINT = (bf16_t*)(ws + WS_WINT); bf16_t* WCAT = (bf16_t*)(ws + WS_WCAT); bf16_t* WOUT = (bf16_t*)(ws + WS_WOUT);
    bf16_t* UW = (bf16_t*)(ws + WS_U); bf16_t* SGP = (bf16_t*)(ws + WS_SGP); bf16_t* CAT = (bf16_t*)(ws + WS_CAT); bf16_t* QA = (bf16_t*)(ws + WS_QA);
    bf16_t* GMP = (bf16_t*)(ws + WS_GMP); bf16_t* GMM = (bf16_t*)(ws + WS_GMM); float* KVA = (float*)((unsigned char*)P.out + OUT_KVA);
    bf16_t* H = (bf16_t*)P.out; bf16_t* Z = SGP;
    volatile LAS unsigned* st = (volatile LAS unsigned*)(ldsl + LDS_BYTES - 16);
    if (threadIdx.x < 4) st[threadIdx.x] = 0u;
    __syncthreads();
    XcdBarrier xb; xb.bar = (unsigned*)(ws + WS_BAR); xb.x = xb_xcc_id(); xb.st = st;
    if (threadIdx.x == 0) (void)xb_add(&xb.bar[XB_XCNT(xb.x)], 1u);
#define GRID_BAR() xcd_barrier(xb, wid)
    PH_BEGIN(0) p0_prep(P, lds, ldsl, wid); PH_END(0)
    if (P.ws == nullptr) grid.sync();
    const bool split = false;
    pg8::Epi1 e1{UW, SGP, QA, CAT, GMP, GMM, KVA, P.b_gate};
    PH_BEGIN(1) p1_h(P, wid); PH_END(1)
    GRID_BAR();
    PH_BEGIN(2)
    {
        pg8::Gemm g{H, WINT, 1024, 1024, 1024, 0}; pg8::StaticOrder so; so.init(M / 256, N1 / 256, G, bid, split ? 0 : MC / 256);
        pg8::gemm_phase(ldsl, g, so, e1, wid);
    }
    PH_END(2)
    GRID_BAR();
    PH_BEGIN(3) p3_thin(P, wid, ldsl, split, e1); PH_END(3)
    GRID_BAR();
    PH_BEGIN(5) p5_attn(P, ldsl, wid); PH_END(5)
    GRID_BAR();
    PH_BEGIN(6)
    {
        pg8::Gemm g{CAT, WCAT, 3072, 3072, 3072, 0}; pg8::StaticOrder so; so.init(M / 256, 4, G, bid, 0);
        pg8::Epi3 e{GMM, Z}; pg8::Hook3 hk{GMP, GMM};
        pg8::gemm_phase(ldsl, g, so, e, wid, hk);
    }
    PH_END(6)
    GRID_BAR();
    PH_BEGIN(7)
    {
        pg8::Gemm g{Z, WOUT, 1024, 1024, 1024, 0}; pg8::StaticOrder so; so.init(M / 256, 4, G, bid, 0);
        pg8::Epi4 e{(const float*)(ws + WS_ADA), UW};
        pg8::gemm_phase(ldsl, g, so, e, wid);
    }
    PH_END(7)
    GRID_BAR();
    PH_BEGIN(8) p8_final(P, wid); PH_END(8)
}

extern "C" void kernel_launch(void* const* d_in, const int* in_sizes, int n_in, void* d_out, int out_size, void* d_ws, size_t ws_size, hipStream_t stream) {
    static int grid_blocks = 0;
    if (grid_blocks == 0) {
        if (n_in != 19 || out_size != M * D || ws_size < WS_END) { fprintf(stderr, "kernel_launch: unexpected shapes (n_in %d out %d ws %zu need %zu)\n", n_in, out_size, ws_size, (size_t)WS_END); grid_blocks = -1; return; }
        int dev = 0, cus = 0, per_cu = 0;
        (void)hipGetDevice(&dev); (void)hipDeviceGetAttribute(&cus, hipDeviceAttributeMultiprocessorCount, dev);
        if (hipFuncSetAttribute((const void*)fwd_megakernel, hipFuncAttributeMaxDynamicSharedMemorySize, LDS_BYTES) != hipSuccess) { fprintf(stderr, "kernel_launch: hipFuncSetAttribute failed\n"); grid_blocks = -1; return; }
        if (hipOccupancyMaxActiveBlocksPerMultiprocessor(&per_cu, (const void*)fwd_megakernel, NTHREADS, LDS_BYTES) != hipSuccess || per_cu < 1) { fprintf(stderr, "kernel_launch: occupancy query failed (%d)\n", per_cu); grid_blocks = -1; return; }
        grid_blocks = cus * 1;
        fprintf(stderr, "kernel_launch: cus %d per_cu %d grid %d\n", cus, per_cu, grid_blocks);
    }
    if (grid_blocks < 0) return;
    Params p{};
    const float** pf = (const float**)&p;
    for (int i = 0; i < 19; ++i) pf[i] = (const float*)d_in[i];
    p.out = (float*)d_out; p.ws = (unsigned char*)d_ws;
    if (hipMemsetAsync((char*)d_ws + WS_BAR, 0, BAR_BYTES, stream) != hipSuccess) { fprintf(stderr, "kernel_launch: memset failed\n"); return; }
    void* args[] = {&p};
    hipError_t e = hipLaunchCooperativeKernel((const void*)fwd_megakernel, dim3(grid_blocks), dim3(NTHREADS), args, LDS_BYTES, stream);
    if (e != hipSuccess) fprintf(stderr, "kernel_launch: cooperative launch failed: %s (grid %d)\n", hipGetErrorString(e), grid_blocks);
}
```

```cpp
#include <hip/hip_runtime.h>
#include <hip/hip_cooperative_groups.h>
#include <cstdint>
#include <cstdio>
namespace cg = cooperative_groups;

#ifndef PROBE_ATTN
#define PROBE_ATTN 0
#endif
#define AT_BEGIN(k) unsigned long long at0_ = 0; if (PROBE_ATTN == (k)) at0_ = __builtin_amdgcn_s_memrealtime();
#define AT_END(k) if (PROBE_ATTN == (k)) { const unsigned long long t1_ = __builtin_amdgcn_s_memrealtime(); while (__builtin_amdgcn_s_memrealtime() - t1_ < t1_ - at0_) __builtin_amdgcn_s_sleep(8); }
typedef unsigned short bf16_t;
typedef short bf16x8 __attribute__((ext_vector_type(8)));
typedef float f32x4 __attribute__((ext_vector_type(4)));
typedef unsigned u32x4 __attribute__((ext_vector_type(4)));
typedef unsigned u32x2 __attribute__((ext_vector_type(2)));
#define LAS __attribute__((address_space(3)))

constexpr int D = 1024, NB = 16, S = 2048, CTX = 256, M = NB * S, MC = NB * CTX, MT = M + MC, NKEY = S + CTX;
constexpr int NH = 16, QKN = 128, QKR = 64, VD = 128, QL = 256, KVL = 128, QKD = QKN + QKR;
constexpr int INW = 6592, N1 = 6656;
constexpr int C_U = 0, C_GP = 1024, C_QA = 2048, C_GM = 2304, C_MP = 4352, C_MM = 5376, C_KV = 6400;
constexpr float EPS = 1e-6f;
constexpr int NTHREADS = 512, NWAVES = 8;
constexpr int LDS_BYTES = 147456;

constexpr size_t al256(size_t x) { return (x + 255) / 256 * 256; }
constexpr size_t WS_ADA   = 0;
constexpr size_t WS_ROPE  = WS_ADA   + al256((size_t)17 * 3072 * 4);
constexpr size_t WS_WINT  = WS_ROPE  + al256((size_t)64 * 16 * 2 * 4);
constexpr size_t WS_WCAT  = WS_WINT  + al256((size_t)N1 * D * 2);
constexpr size_t WS_WOUT  = WS_WCAT  + al256((size_t)1024 * 3072 * 2);
constexpr size_t WS_WQT   = WS_WOUT  + al256((size_t)1024 * 1024 * 2);
constexpr size_t WS_WVBT  = WS_WQT   + al256((size_t)NH * QKD * QL * 2);
constexpr size_t WS_U     = WS_WVBT  + al256((size_t)NH * VD * KVL * 2);
constexpr size_t WS_SGP   = WS_U     + al256((size_t)M * 1024 * 2);
constexpr size_t WS_CAT   = WS_SGP   + al256((size_t)M * 1024 * 2);
constexpr size_t WS_QA    = WS_CAT   + al256((size_t)M * 3072 * 2);
constexpr size_t WS_GMP   = WS_QA    + al256((size_t)M * 256 * 2);
constexpr size_t WS_GMM   = WS_GMP   + al256((size_t)M * 1024 * 2);
constexpr size_t WS_KC    = WS_GMM   + al256((size_t)M * 1024 * 2);
constexpr size_t WS_BAR   = WS_KC    + al256((size_t)NB * NKEY * QKD * 2);
constexpr size_t OUT_KVA  = (size_t)80 << 20;
constexpr size_t BAR_BYTES = 16384;
constexpr int ADA_CNT_WORD = 3584;
constexpr size_t WS_END   = WS_BAR   + BAR_BYTES;

struct Params {
    const float *x, *c, *ctx, *c_ctx, *ada_w, *ada_b, *norm_g, *w_in, *b_gate, *w_pool, *pool_scale, *q_norm_g, *w_qb, *kv_norm_g, *w_kvb, *w_pp, *w_pm, *w_out, *final_g;
    float* out; unsigned char* ws;
};

__device__ __forceinline__ bf16_t f2bf(float f) { unsigned u = __float_as_uint(f); u += 0x7fffu + ((u >> 16) & 1u); return (bf16_t)(u >> 16); }
__device__ __forceinline__ float bf2f(bf16_t b) { return __uint_as_float(((unsigned)b) << 16); }
__device__ __forceinline__ float bflo(unsigned w) { return __uint_as_float(w << 16); }
__device__ __forceinline__ float bfhi(unsigned w) { return __uint_as_float(w & 0xffff0000u); }
__device__ __forceinline__ u32x2 cvt2_pk_bf16(float a0, float a1, float a2, float a3) { u32x2 r;
    asm volatile("s_nop 0\n\tv_cvt_pk_bf16_f32 %0, %2, %3\n\tv_cvt_pk_bf16_f32 %1, %4, %5" : "=&v"(r.x), "=v"(r.y) : "v"(a0), "v"(a1), "v"(a2), "v"(a3)); return r; }
__device__ __forceinline__ u32x4 cvt4_pk_bf16(float a0, float a1, float a2, float a3, float a4, float a5, float a6, float a7) { u32x4 r;
    asm volatile("s_nop 0\n\tv_cvt_pk_bf16_f32 %0, %4, %5\n\tv_cvt_pk_bf16_f32 %1, %6, %7\n\tv_cvt_pk_bf16_f32 %2, %8, %9\n\tv_cvt_pk_bf16_f32 %3, %10, %11"
                 : "=&v"(r.x), "=&v"(r.y), "=&v"(r.z), "=v"(r.w) : "v"(a0), "v"(a1), "v"(a2), "v"(a3), "v"(a4), "v"(a5), "v"(a6), "v"(a7)); return r; }
__device__ __forceinline__ float siluf(float v) { return v / (1.f + __expf(-v)); }
__device__ __forceinline__ float sigmf(float v) { return 1.f / (1.f + __expf(-v)); }
__device__ __forceinline__ int lane_id() { unsigned z = 0u; asm volatile("" : "+v"(z)); return (int)__builtin_amdgcn_mbcnt_hi(~0u, __builtin_amdgcn_mbcnt_lo(~0u, z)); }
template <int K> __device__ __forceinline__ float swz_xor(float v) { return __uint_as_float((unsigned)__builtin_amdgcn_ds_swizzle((int)__float_as_uint(v), (K << 10) | 0x1f)); }
__device__ __forceinline__ float half_swap_sum(float v) { auto rr = __builtin_amdgcn_permlane32_swap(__float_as_uint(v), __float_as_uint(v), false, false); return __uint_as_float(rr[0]) + __uint_as_float(rr[1]); }
__device__ __forceinline__ float half_swap_max(float v) { auto rr = __builtin_amdgcn_permlane32_swap(__float_as_uint(v), __float_as_uint(v), false, false); return fmaxf(__uint_as_float(rr[0]), __uint_as_float(rr[1])); }
__device__ __forceinline__ float wave_sum(float v) {
    v += swz_xor<1>(v); v += swz_xor<2>(v); v += swz_xor<4>(v); v += swz_xor<8>(v); v += swz_xor<16>(v);
    return half_swap_sum(v);
}
__device__ __forceinline__ float wave_max(float v) {
    v = fmaxf(v, swz_xor<1>(v)); v = fmaxf(v, swz_xor<2>(v)); v = fmaxf(v, swz_xor<4>(v)); v = fmaxf(v, swz_xor<8>(v)); v = fmaxf(v, swz_xor<16>(v));
    return half_swap_max(v);
}

#define XB_TMO      128
#define XB_XCNT(j)  (256  + 64 * (j))
#define XB_XSUB(j)  (1280 + 64 * (j))
#define XB_XGEN(j)  (2304 + 64 * (j))
#define XB_TOP      3328
#define XB_TOPGEN   3392
#define XB_SPIN_CAP (1u << 24)
__device__ __forceinline__ unsigned xb_ld(unsigned* p)              { return __hip_atomic_load(p, __ATOMIC_RELAXED, __HIP_MEMORY_SCOPE_AGENT); }
__device__ __forceinline__ unsigned xb_add(unsigned* p, unsigned v) { return __hip_atomic_fetch_add(p, v, __ATOMIC_RELAXED, __HIP_MEMORY_SCOPE_AGENT); }
__device__ __forceinline__ unsigned xb_xcc_id() { return (unsigned)__builtin_amdgcn_s_getreg((3 << 11) | 20) & 0xFu; }
#define XB_SPIN(cond, bar) do { unsigned _sp = 0; while (cond) { __builtin_amdgcn_s_sleep(1); \
    if ((++_sp & 255u) == 0u) { if (xb_ld(&(bar)[XB_TMO])) break; if (_sp > XB_SPIN_CAP) { atomicAdd(&(bar)[XB_TMO], 1u); break; } } } } while (0)
struct XcdBarrier { unsigned* bar; unsigned x; volatile LAS unsigned* st; };
__device__ __forceinline__ void xcd_barrier_complete(unsigned* bar, unsigned x, unsigned& nloc, unsigned& nx) {
    const unsigned G = gridDim.x * gridDim.y * gridDim.z;
    unsigned sum, cnt, mine, sp = 0u;
    for (;;) {
        sum = 0u; cnt = 0u; mine = 0u;
#pragma unroll
        for (unsigned j = 0; j < 16; ++j) { const unsigned c = xb_ld(&bar[XB_XCNT(j)]); sum += c; cnt += (c > 0u) ? 1u : 0u; mine = (j == x) ? c : mine; }
        if (sum == G) break;
        __builtin_amdgcn_s_sleep(1);
        if ((++sp & 255u) == 0u) { if (xb_ld(&bar[XB_TMO])) break; if (sp > XB_SPIN_CAP) { atomicAdd(&bar[XB_TMO], 1u); break; } }
    }
    nloc = mine > 0u ? mine : 1u; nx = cnt > 0u ? cnt : 1u;
}
__device__ __forceinline__ void xcd_barrier(const XcdBarrier& b, const int wid) {
    const bool leader = (wid == 0) && (lane_id() == 0);
    asm volatile("s_waitcnt vmcnt(0)" ::: "memory");
    __syncthreads();
    if (leader) {
        unsigned* bar = b.bar;
        __builtin_amdgcn_s_waitcnt(0);
        unsigned nloc = b.st[0], nx = b.st[1];
        if (nloc == 0u) { xcd_barrier_complete(bar, b.x, nloc, nx); b.st[0] = nloc; b.st[1] = nx; }
        const unsigned old = xb_add(&bar[XB_XSUB(b.x)], 1u);
        const unsigned gen = old / nloc;
        if (old + 1u == (gen + 1u) * nloc) {
            __builtin_amdgcn_fence(__ATOMIC_RELEASE, "agent");
            asm volatile("s_waitcnt vmcnt(0)" ::: "memory");
            const unsigned og = xb_add(&bar[XB_TOP], 1u);
            const unsigned tg = og / nx;
            if (og + 1u == (tg + 1u) * nx) xb_add(&bar[XB_TOPGEN], 1u);
            else XB_SPIN(xb_ld(&bar[XB_TOPGEN]) == tg, bar);
            __builtin_amdgcn_fence(__ATOMIC_ACQUIRE, "agent");
            xb_add(&bar[XB_XGEN(b.x)], 1u);
            asm volatile("s_waitcnt vmcnt(0)" ::: "memory");
        } else {
            XB_SPIN(xb_ld(&bar[XB_XGEN(b.x)]) == gen, bar);
            __builtin_amdgcn_fence(__ATOMIC_ACQUIRE, "agent");
            asm volatile("s_waitcnt vmcnt(0)" ::: "memory");
        }
    }
    __syncthreads();
}

__device__ __forceinline__ void xcd_barrier_arrive_only(const XcdBarrier& b, const bool leader) {
    if (leader) {
        unsigned* bar = b.bar;
        __builtin_amdgcn_s_waitcnt(0);
        unsigned nloc = b.st[0], nx = b.st[1];
        if (nloc == 0u) { xcd_barrier_complete(bar, b.x, nloc, nx); b.st[0] = nloc; b.st[1] = nx; }
        const unsigned old = xb_add(&bar[XB_XSUB(b.x)], 1u);
        const unsigned gen = old / nloc;
        if (old + 1u == (gen + 1u) * nloc) {
            __builtin_amdgcn_fence(__ATOMIC_RELEASE, "agent");
            asm volatile("s_waitcnt vmcnt(0)" ::: "memory");
            const unsigned og = xb_add(&bar[XB_TOP], 1u);
            const unsigned tg = og / nx;
            if (og + 1u == (tg + 1u) * nx) xb_add(&bar[XB_TOPGEN], 1u);
            else XB_SPIN(xb_ld(&bar[XB_TOPGEN]) == tg, bar);
            __builtin_amdgcn_fence(__ATOMIC_ACQUIRE, "agent");
            xb_add(&bar[XB_XGEN(b.x)], 1u);
            asm volatile("s_waitcnt vmcnt(0)" ::: "memory");
            b.st[2] = 0u;
        } else b.st[2] = gen + 1u;
    }
}
__device__ __forceinline__ void xcd_barrier_finish(const XcdBarrier& b, const int wid) {
    const bool leader = (wid == 0) && (lane_id() == 0);
    if (leader) { const unsigned pend = b.st[2];
        if (pend) { unsigned* bar = b.bar; const unsigned gen = pend - 1u; XB_SPIN(xb_ld(&bar[XB_XGEN(b.x)]) == gen, bar);
            __builtin_amdgcn_fence(__ATOMIC_ACQUIRE, "agent"); asm volatile("s_waitcnt vmcnt(0)" ::: "memory"); b.st[2] = 0u; } }
    __syncthreads();
}

namespace pg8 {
constexpr int BM = 256, BK = 64, HALF = 128, HTB = HALF * BK * 2  , NXCD = 8, WGM = 8;
__host__ __device__ __forceinline__ int lds_byte(int r, int c) { const int st = (r >> 4) * 2 + (c >> 5), rr = r & 15, cc = c & 31, ob = rr * 64 + cc * 2; return st * 1024 + (ob ^ (((ob >> 9) & 1) << 5)); }
__host__ __device__ __forceinline__ void stage_rc(int b, int& R, int& C) { const int st = b / 1024, sb = b % 1024, swz = sb ^ (((sb >> 9) & 1) << 5); R = (st >> 1) * 16 + swz / 64; C = (st & 1) * 32 + (swz % 64) / 2; }
__host__ __device__ __forceinline__ int perm32(int rho) { const int n = rho >> 4, i = rho & 15; return 8 * (i >> 2) + 4 * n + (i & 3); }

struct Unit { int pm, pn; };
struct Gemm { const bf16_t* A; const bf16_t* Bt; int lda, ldb, K, a_koff_pn; };

struct StaticOrder {
    int nM, nN, nwg, G, c, extra; bool late8 = false, rev2 = false; int arrive_ui = -1; XcdBarrier xb = {nullptr, 0u, nullptr};
    __device__ void init(int nM_, int nN_, int G_, int c_, int extra_) { nM = nM_; nN = nN_; nwg = nM * nN; G = G_; c = c_; extra = extra_; }
    __device__ bool next(int i, Unit& u) const {
        const long L = (long)((rev2 && nwg == 2 * G) ? 1 - i : i) * G + c; if (i < 0 || L < 0 || L >= nwg + extra) return false;
        if (L >= nwg) { u.pm = nM + (int)(L - nwg); u.pn = nN - 1; return true; }
        int wgid = (int)L; { const int q = nwg / NXCD, r = nwg % NXCD, xcd = wgid % NXCD, off = wgid / NXCD; wgid = (xcd < r ? xcd * (q + 1) : r * (q + 1) + (xcd - r) * q) + off; }
        if (late8) {
            const int xb = wgid / 416, w = wgid % 416;
            if (w < 288) { const int gq = w / 72, idx = w % 72; u.pm = xb * 16 + gq * 4 + (idx & 3); u.pn = 8 + (idx >> 2); }
            else { const int w2 = w - 288, gq = w2 >> 5, idx = w2 & 31; u.pm = xb * 16 + gq * 4 + (idx & 3); u.pn = idx >> 2; }
            return true;
        }
        const int nig = WGM * nN, gid = wgid / nig, fm = gid * WGM, gsz = (nM - fm) < WGM ? (nM - fm) : WGM;
        u.pm = fm + ((wgid % nig) % gsz); u.pn = (wgid % nig) / gsz; return true;
    }
};

typedef f32x4 Acc[2][2][4][2];

struct NoHook { static constexpr int T = -1; __device__ __forceinline__ void operator()(Acc&, const Unit&, int, int, int, int) const {} };
struct OneUnit { Unit u; int arrive_ui = -1; XcdBarrier xb = {nullptr, 0u, nullptr}; __device__ bool next(int i, Unit& o) const { if (i != 0) return false; o = u; return true; } };
template <class Epi, class Hook = NoHook, class Sched = StaticOrder>
__device__ __forceinline__ void gemm_phase(LAS unsigned char* lds, const Gemm g, const Sched& S, const Epi& E, const int wid, const Hook& H = Hook()) {
    const int lane = lane_id(), tid = wid * 64 + lane, wr = wid >> 2, wc = wid & 3, fr = lane & 15, fq = lane >> 4;
    const int K = g.K, nt = K / BK;
    unsigned voffA[2], voffB[2];
#pragma unroll
    for (int i = 0; i < 2; ++i) { int R, C; stage_rc(tid * 16 + i * 8192, R, C); const int Rb = (R & ~31) + perm32(R & 31);
        voffA[i] = (unsigned)(R * g.lda + C) * 2u; voffB[i] = (unsigned)(Rb * g.ldb + C) * 2u; }
    const size_t kstep = (size_t)(BK * 2);
    const size_t hstepA = (size_t)HALF * g.lda * 2, hstepB = (size_t)HALF * g.ldb * 2;
    const size_t tstepA = 2 * hstepA, tstepB = 2 * hstepB;
    const unsigned ldsw = (unsigned)wid * 1024u;
    const int aoff = lds_byte(wr * 64 + fr, fq * 8), boff = lds_byte(wc * 32 + fr, fq * 8);
#define PG8_SA(b, h) (((b) * 2 + (h)) * HTB)
#define PG8_SB(b, h) ((4 + (b) * 2 + (h)) * HTB)
#define PG8_STAGE(bufoff, gbase, voff) do { _Pragma("unroll") for (int _i = 0; _i < 2; ++_i) \
        __builtin_amdgcn_global_load_lds((const unsigned*)((const char*)(gbase) + (voff)[_i]), (LAS unsigned*)(lds + (bufoff) + ldsw + _i * 8192), 16, 0, 0); } while (0)
#define PG8_LDA(dst, b, h) do { _Pragma("unroll") for (int m = 0; m < 4; ++m) _Pragma("unroll") for (int k = 0; k < 2; ++k) dst[m][k] = *(const LAS bf16x8*)(lds + PG8_SA(b, h) + aoff + m * 2048 + k * 1024); } while (0)
#define PG8_LDB(dst, b, h) do { _Pragma("unroll") for (int n = 0; n < 2; ++n) _Pragma("unroll") for (int k = 0; k < 2; ++k) dst[n][k] = *(const LAS bf16x8*)(lds + PG8_SB(b, h) + boff + n * 2048 + k * 1024); } while (0)
#define PG8_MMA(ai, bj, At, Bt) do { __builtin_amdgcn_s_setprio(1); _Pragma("unroll") for (int m = 0; m < 4; ++m) _Pragma("unroll") for (int n = 0; n < 2; ++n) _Pragma("unroll") for (int k = 0; k < 2; ++k) \
        acc[ai][bj][m][n] = __builtin_amdgcn_mfma_f32_16x16x32_bf16(Bt[n][k], At[m][k], acc[ai][bj][m][n], 0, 0, 0); __builtin_amdgcn_s_setprio(0); } while (0)
#define PG8_WAIT_V(n) asm volatile("s_waitcnt vmcnt(" #n ")" ::: "memory")
#define PG8_WAIT_L(n) asm volatile("s_waitcnt lgkmcnt(" #n ")" ::: "memory")
#define PG8_BAR __builtin_amdgcn_s_barrier()
#define PG8_SCHED __builtin_amdgcn_sched_barrier(0)
    Unit cur, nxt; int ui = 0;
    if (!S.next(0, cur)) return;
    Acc acc;
#pragma unroll
    for (int a = 0; a < 2; ++a)
#pragma unroll
        for (int b = 0; b < 2; ++b)
#pragma unroll
            for (int m = 0; m < 4; ++m)
#pragma unroll
                for (int n = 0; n < 2; ++n) acc[a][b][m][n] = (f32x4){0.f, 0.f, 0.f, 0.f};
    bf16x8 At[4][2], B0[2][2], B1[2][2];
    const char* cA = (const char*)g.A + (size_t)cur.pm * tstepA + (size_t)cur.pn * g.a_koff_pn * 2; const char* cB = (const char*)g.Bt + (size_t)cur.pn * tstepB;
    PG8_STAGE(PG8_SB(0, 0), cB, voffB); PG8_STAGE(PG8_SB(0, 1), cB + hstepB, voffB); PG8_STAGE(PG8_SA(0, 0), cA, voffA); PG8_STAGE(PG8_SA(0, 1), cA + hstepA, voffA);
    if (wr == 1) PG8_BAR;
    PG8_WAIT_V(2); PG8_BAR;
    PG8_STAGE(PG8_SB(1, 0), cB + kstep, voffB); PG8_STAGE(PG8_SA(1, 0), cA + kstep, voffA); PG8_STAGE(PG8_SB(1, 1), cB + hstepB + kstep, voffB);
    PG8_WAIT_V(6); PG8_BAR;
    for (;;) {
        const bool has_next = S.next(ui + 1, nxt);
        const char* nA = has_next ? (const char*)g.A + (size_t)nxt.pm * tstepA + (size_t)nxt.pn * g.a_koff_pn * 2 : cA; const char* nB = has_next ? (const char*)g.Bt + (size_t)nxt.pn * tstepB : cB;
        for (int t = 0; t < nt; t += 2) {
            const bool last = (t == nt - 2);
            const char* a1 = cA + (size_t)(t + 1) * kstep;
            const char* a2 = last ? nA : cA + (size_t)(t + 2) * kstep; const char* b2 = last ? nB : cB + (size_t)(t + 2) * kstep;
            const char* a3 = a2 + kstep; const char* b3 = b2 + kstep;
            if constexpr (Hook::T >= 0) { if (t == Hook::T) H(acc, cur, wr, wc, fr, fq); }
            PG8_LDB(B0, 0, 0); PG8_LDB(B1, 0, 1); PG8_SCHED; PG8_LDA(At, 0, 0); PG8_STAGE(PG8_SA(1, 1), a1 + hstepA, voffA);
            PG8_WAIT_V(8); PG8_WAIT_L(0); PG8_BAR; PG8_MMA(0, 0, At, B0); PG8_MMA(0, 1, At, B1); PG8_BAR; PG8_SCHED;
            PG8_LDA(At, 0, 1); PG8_STAGE(PG8_SB(0, 0), b2, voffB); PG8_STAGE(PG8_SB(0, 1), b2 + hstepB, voffB); PG8_STAGE(PG8_SA(0, 0), a2, voffA);
            PG8_WAIT_V(8); PG8_WAIT_L(0); PG8_BAR; PG8_MMA(1, 0, At, B0); PG8_MMA(1, 1, At, B1); PG8_BAR; PG8_SCHED;
            PG8_LDB(B0, 1, 0); PG8_LDB(B1, 1, 1); PG8_SCHED; PG8_LDA(At, 1, 0); PG8_STAGE(PG8_SA(0, 1), a2 + hstepA, voffA);
            PG8_WAIT_V(8); PG8_WAIT_L(0); PG8_BAR; PG8_MMA(0, 0, At, B0); PG8_MMA(0, 1, At, B1); PG8_BAR; PG8_SCHED;
            PG8_LDA(At, 1, 1); PG8_STAGE(PG8_SB(1, 0), b3, voffB); PG8_STAGE(PG8_SB(1, 1), b3 + hstepB, voffB); PG8_STAGE(PG8_SA(1, 0), a3, voffA);
            PG8_WAIT_V(8); PG8_WAIT_L(0); PG8_BAR; PG8_MMA(1, 0, At, B0); PG8_MMA(1, 1, At, B1); PG8_BAR; PG8_SCHED;
        }
        if (wr == 0) PG8_BAR;
        asm volatile("s_nop 15\n\ts_nop 15" ::: "memory");
        E(acc, cur, wr, wc, fr, fq);
        if (S.arrive_ui == ui) { asm volatile("s_waitcnt vmcnt(0)" ::: "memory"); PG8_BAR; xcd_barrier_arrive_only(S.xb, wid == 0 && lane == 0); }
        if (!has_next) break;
#pragma unroll
        for (int a = 0; a < 2; ++a)
#pragma unroll
            for (int b = 0; b < 2; ++b)
#pragma unroll
                for (int m = 0; m < 4; ++m)
#pragma unroll
                    for (int n = 0; n < 2; ++n) acc[a][b][m][n] = (f32x4){0.f, 0.f, 0.f, 0.f};
        cur = nxt; cA = nA; cB = nB; ++ui;
        if (wr == 1) PG8_BAR;
    }
    PG8_WAIT_V(0);
    PG8_BAR;
#undef PG8_SA
#undef PG8_SB
#undef PG8_STAGE
#undef PG8_LDA
#undef PG8_LDB
#undef PG8_MMA
#undef PG8_WAIT_V
#undef PG8_WAIT_L
#undef PG8_BAR
#undef PG8_SCHED
}

#define EPI_FOREACH(...) _Pragma("unroll") for (int ai = 0; ai < 2; ++ai) _Pragma("unroll") for (int m = 0; m < 4; ++m) { const int row = u.pm * BM + ai * HALF + wr * 64 + m * 16 + fr; \
        _Pragma("unroll") for (int bj = 0; bj < 2; ++bj) { const int ct = bj * HALF + wc * 32 + 8 * fq; const f32x4 v0 = acc[ai][bj][m][0], v1 = acc[ai][bj][m][1]; __VA_ARGS__ } }
__device__ __forceinline__ u32x4 pack8(const f32x4 a, const f32x4 b) { return cvt4_pk_bf16(a[0], a[1], a[2], a[3], b[0], b[1], b[2], b[3]); }
__device__ __forceinline__ void unpack8(const u32x4 w, f32x4& a, f32x4& b) { a = (f32x4){bflo(w.x), bfhi(w.x), bflo(w.y), bfhi(w.y)}; b = (f32x4){bflo(w.z), bfhi(w.z), bflo(w.w), bfhi(w.w)}; }
__device__ __forceinline__ f32x4 act4(f32x4 v, int mode) {
    f32x4 o;
#pragma unroll
    for (int j = 0; j < 4; ++j) { const float s = __builtin_amdgcn_rcpf(1.f + __expf(-v[j])); o[j] = mode == 1 ? v[j] * s : s; }
    return o;
}
struct Epi1 {
    bf16_t *UW, *SGP, *QA, *CAT, *GMP, *GMM; float* KVA; const float* b_gate;
    __device__ __forceinline__ void operator()(const Acc& acc, const Unit& u, int wr, int wc, int fr, int fq) const {
        const int pn = u.pn;
        if (pn >= 17 && pn < 25) {
            const int cb = (pn - 17) * 128 + wc * 32 + 8 * fq;
            const f32x4 bp0 = *(const f32x4*)(b_gate + cb), bp1 = *(const f32x4*)(b_gate + cb + 4), bm0 = *(const f32x4*)(b_gate + 1024 + cb), bm1 = *(const f32x4*)(b_gate + 1024 + cb + 4);
#pragma unroll
            for (int ai = 0; ai < 2; ++ai)
#pragma unroll
                for (int m = 0; m < 4; ++m) { const size_t o = (size_t)(u.pm * BM + ai * HALF + wr * 64 + m * 16 + fr) * 1024 + cb;
                    const f32x4 p0 = act4(acc[ai][0][m][0] + bp0, 2), p1 = act4(acc[ai][0][m][1] + bp1, 2), q0 = act4(acc[ai][1][m][0] + bm0, 2), q1 = act4(acc[ai][1][m][1] + bm1, 2); f32x4 r0, r1;
#pragma unroll
                    for (int j = 0; j < 4; ++j) { r0[j] = p0[j] * __builtin_amdgcn_rcpf(q0[j]); r1[j] = p1[j] * __builtin_amdgcn_rcpf(q1[j]); }
                    *(u32x4*)(GMM + o) = pack8(q0, q1); *(u32x4*)(GMP + o) = pack8(r0, r1); }
            return;
        }
        if (pn == 8) {
            EPI_FOREACH({ *(u32x4*)(QA + ((size_t)(row >> 5) * 8192 + (size_t)(ct >> 4) * 512 + (size_t)(row & 31) * 16 + (ct & 8))) = pack8(v0, v1); }) return; }
        if (pn == 25) { EPI_FOREACH({ float* p = KVA + (size_t)row * 256 + ct; *(f32x4*)p = v0; *(f32x4*)(p + 4) = v1; }) return; }
        bf16_t* base; int ld, c0, mode = 0; const float* bias = nullptr;
        if (pn < 4) { base = UW; ld = 1024; c0 = pn * 256; }
        else if (pn < 8) { base = SGP; ld = 1024; c0 = (pn - 4) * 256; mode = 1; }
        else if (pn < 9) { base = QA; ld = 256; c0 = 0; }
        else if (pn < 17) { base = CAT; ld = 3072; c0 = 1024 + (pn - 9) * 256; mode = 1; }
        else if (pn < 21) { base = GMP; ld = 1024; c0 = (pn - 17) * 256; mode = 2; bias = b_gate + c0; }
        else { base = GMM; ld = 1024; c0 = (pn - 21) * 256; mode = 2; bias = b_gate + 1024 + c0; }
        if (mode == 0) { EPI_FOREACH({ *(u32x4*)(base + (size_t)row * ld + c0 + ct) = pack8(v0, v1); }) }
        else if (mode == 1) { EPI_FOREACH({ *(u32x4*)(base + (size_t)row * ld + c0 + ct) = pack8(act4(v0, 1), act4(v1, 1)); }) }
        else { f32x4 bb[2][2];
#pragma unroll
               for (int bj = 0; bj < 2; ++bj) { const float* pb = bias + bj * HALF + wc * 32 + 8 * fq; bb[bj][0] = *(const f32x4*)pb; bb[bj][1] = *(const f32x4*)(pb + 4); }
               EPI_FOREACH({ *(u32x4*)(base + (size_t)row * ld + c0 + ct) = pack8(act4(v0 + bb[bj][0], 2), act4(v1 + bb[bj][1], 2)); }) }
    }
};
template <bool RATIO> struct Hook3 {
    static constexpr int T = 16;
    const bf16_t *GMP, *GMM;
    __device__ __forceinline__ void operator()(Acc& acc, const Unit& u, int wr, int wc, int fr, int fq) const {
        if constexpr (RATIO) {
            unsigned off = ((unsigned)(u.pm * BM + wr * 64 + fr) * 1024u + (unsigned)(u.pn * 256 + wc * 32 + 8 * fq)) * 2u;
#pragma unroll
            for (int ai = 0; ai < 2; ++ai) {
                asm volatile("" : "+v"(off) :: "memory");
                u32x4 rr[4][2];
#pragma unroll
                for (int m = 0; m < 4; ++m)
#pragma unroll
                    for (int bj = 0; bj < 2; ++bj) rr[m][bj] = *(const u32x4*)((const char*)GMP + off + m * 32768 + bj * 256);
#pragma unroll
                for (int m = 0; m < 4; ++m)
#pragma unroll
                    for (int bj = 0; bj < 2; ++bj) { f32x4 p0, p1; unpack8(rr[m][bj], p0, p1); acc[ai][bj][m][0] *= p0; acc[ai][bj][m][1] *= p1; }
                off += 128u * 2048u;
            }
            return;
        }
        unsigned off = ((unsigned)(u.pm * BM + wr * 64 + fr) * 1024u + (unsigned)(u.pn * 256 + wc * 32 + 8 * fq)) * 2u;
#pragma unroll
        for (int ai = 0; ai < 2; ++ai)
#pragma unroll
            for (int mp = 0; mp < 2; ++mp) {
                asm volatile("" : "+v"(off) :: "memory");
                u32x4 gp[2][2], gm[2][2];
#pragma unroll
                for (int mm = 0; mm < 2; ++mm)
#pragma unroll
                    for (int bj = 0; bj < 2; ++bj) { gp[mm][bj] = *(const u32x4*)((const char*)GMP + off + mm * 32768 + bj * 256); gm[mm][bj] = *(const u32x4*)((const char*)GMM + off + mm * 32768 + bj * 256); }
#pragma unroll
                for (int mm = 0; mm < 2; ++mm)
#pragma unroll
                    for (int bj = 0; bj < 2; ++bj) { const int m = mp * 2 + mm; f32x4 p0, p1, q0, q1; unpack8(gp[mm][bj], p0, p1); unpack8(gm[mm][bj], q0, q1);
#pragma unroll
                        for (int j = 0; j < 4; ++j) { acc[ai][bj][m][0][j] *= p0[j] * __builtin_amdgcn_rcpf(q0[j]); acc[ai][bj][m][1][j] *= p1[j] * __builtin_amdgcn_rcpf(q1[j]); } }
                off += (mp == 1 ? 96u : 32u) * 2048u;
            }
    }
};
struct Epi3 {
    const bf16_t* GMM; bf16_t* Z;
    __device__ __forceinline__ void operator()(const Acc& acc, const Unit& u, int wr, int wc, int fr, int fq) const {
        u32x4 gt[2][4][2];
#pragma unroll
        for (int ai = 0; ai < 2; ++ai)
#pragma unroll
            for (int m = 0; m < 4; ++m)
#pragma unroll
                for (int bj = 0; bj < 2; ++bj) gt[ai][m][bj] = *(const u32x4*)(GMM + (size_t)(u.pm * BM + ai * HALF + wr * 64 + m * 16 + fr) * 1024 + u.pn * 256 + bj * HALF + wc * 32 + 8 * fq);
        asm volatile("s_waitcnt vmcnt(0)" ::: "memory"); __builtin_amdgcn_sched_barrier(0);
#pragma unroll
        for (int ai = 0; ai < 2; ++ai)
#pragma unroll
            for (int m = 0; m < 4; ++m)
#pragma unroll
                for (int bj = 0; bj < 2; ++bj) { f32x4 g0, g1; unpack8(gt[ai][m][bj], g0, g1);
                    *(u32x4*)(Z + (size_t)(u.pm * BM + ai * HALF + wr * 64 + m * 16 + fr) * 1024 + u.pn * 256 + bj * HALF + wc * 32 + 8 * fq) = pack8(acc[ai][bj][m][0] * g0, acc[ai][bj][m][1] * g1); }
    }
};
struct Epi4 {
    const float* ada; bf16_t* GY;
    __device__ __forceinline__ void operator()(const Acc& acc, const Unit& u, int wr, int wc, int fr, int fq) const {
        const float* gate = ada + ((u.pm * BM) / S) * 3072 + 2048;
        f32x4 gg[2][2];
#pragma unroll
        for (int bj = 0; bj < 2; ++bj) { const float* pg = gate + u.pn * 256 + bj * HALF + wc * 32 + 8 * fq; gg[bj][0] = *(const f32x4*)pg; gg[bj][1] = *(const f32x4*)(pg + 4); }
        EPI_FOREACH({ const int col = u.pn * 256 + ct; const size_t o = (size_t)row * 1024 + col;
            *(u32x4*)(GY + o) = pack8(gg[bj][0] * v0, gg[bj][1] * v1); })
    }
};
}

__device__ __forceinline__ void tr_item(const float* __restrict__ W, int ld, int N32, bf16_t* __restrict__ dst, int dst_ld, int dst_koff, int mode, const float* __restrict__ kscale,
                                        int item, LAS float* scr, int lane) {
    const int nb = item % N32, kb = item / N32, k0 = 64 * kb, n0 = 32 * nb, nl = lane & 31;
    int n = n0 + nl, col;
    if (mode == 0) col = n;
    else if (mode == 1) { n += 1024;
        if (n >= C_MP && n < C_KV) { const int gidx = n - C_MP, lc = gidx & 255; n = C_MP + (lc >> 7) * 1024 + (gidx >> 8) * 128 + (lc & 127); }
        col = n < C_GM ? n : (n < C_KV ? n + 192 : (n < C_KV + 192 ? n - C_KV + 2304 : -1)); }
    else if (mode == 2) col = (n >> 7) * 256 + 128 + (n & 127);
    else col = (n / 64) * 192 + 128 + (n % 64);
    float tv[32];
#pragma unroll
    for (int i = 0; i < 32; ++i) { const int kk = 2 * i + (lane >> 5), k = k0 + kk;
        const int ks = (mode == 2) ? ((k & ~15) + 8 * ((k & 7) >> 2) + 4 * ((k >> 3) & 1) + (k & 3)) : k;
        tv[i] = col >= 0 ? W[(size_t)ks * ld + col] * (kscale ? kscale[k] : 1.f) : 0.f; }
#pragma unroll
    for (int i = 0; i < 32; ++i) scr[(2 * i + (lane >> 5)) * 33 + nl] = tv[i];
    asm volatile("s_waitcnt lgkmcnt(0)" ::: "memory");
    const int c = lane & 7;
#pragma unroll
    for (int j = 0; j < 4; ++j) { const int nn = (lane >> 3) + 8 * j; const LAS float* sp = scr + (8 * c) * 33 + nn;
        const u32x4 o = cvt4_pk_bf16(sp[0 * 33], sp[1 * 33], sp[2 * 33], sp[3 * 33], sp[4 * 33], sp[5 * 33], sp[6 * 33], sp[7 * 33]);
        int ng = n0 + nn; size_t drow;
        if (mode == 1) drow = 1024 + ng; else if (mode == 3) drow = (size_t)(ng / 64) * 192 + 128 + (ng % 64); else drow = ng;
        *(u32x4*)(dst + drow * dst_ld + dst_koff + k0 + 8 * c) = o; }
    asm volatile("s_waitcnt lgkmcnt(0)" ::: "memory");
}
__device__ __forceinline__ void wqt_role(const Params& P, float* fl, const int tid, const int bid) {
    unsigned char* ws = P.ws;
    const int it = bid - 96, h = it >> 2, k0 = (it & 3) * 64;
    constexpr int AP = 132;
    float* As = fl;
    float* Bs = fl + 64 * AP;
    {
        f32x4 av[4], bv[8];
#pragma unroll
        for (int q = 0; q < 4; ++q) { const int i4 = tid + NTHREADS * q, kk = i4 >> 5, j = (i4 & 31) * 4; av[q] = *(const f32x4*)(P.w_qb + (size_t)(k0 + kk) * 3072 + h * 192 + j); }
#pragma unroll
        for (int q = 0; q < 8; ++q) { const int i4 = tid + NTHREADS * q, l = i4 >> 5, j = (i4 & 31) * 4; bv[q] = *(const f32x4*)(P.w_kvb + (size_t)l * 4096 + h * 256 + j); }
#pragma unroll
        for (int q = 0; q < 4; ++q) { const int i4 = tid + NTHREADS * q, kk = i4 >> 5, j = (i4 & 31) * 4; *(f32x4*)(As + kk * AP + j) = av[q]; }
#pragma unroll
        for (int q = 0; q < 8; ++q) { const int i4 = tid + NTHREADS * q, l = i4 >> 5, j = (i4 & 31) * 4; *(f32x4*)(Bs + l * AP + j) = bv[q]; }
    }
    __syncthreads();
    const int kk = tid & 63, lb = tid >> 6; const float qg = P.q_norm_g[k0 + kk];
    float acc[16];
#pragma unroll
    for (int i = 0; i < 16; ++i) acc[i] = 0.f;
#pragma unroll 2
    for (int j = 0; j < 128; j += 4) {
        const f32x4 a = *(const f32x4*)(As + kk * AP + j);
#pragma unroll
        for (int i = 0; i < 16; ++i) { const f32x4 b = *(const f32x4*)(Bs + (lb + 8 * i) * AP + j); acc[i] += a[0] * b[0] + a[1] * b[1] + a[2] * b[2] + a[3] * b[3]; }
    }
#pragma unroll
    for (int i = 0; i < 16; ++i) ((bf16_t*)(ws + WS_WQT))[((size_t)h * 192 + lb + 8 * i) * 256 + k0 + kk] = f2bf(acc[i] * qg);
    __syncthreads();
}
namespace p0i { constexpr int I_WIN = ((N1 - 1024) / 32) * 16, I_PP = 32 * 16, I_PM = 32 * 32, I_OUT = 32 * 16, I_VB = 64 * 2, I_QR = 32 * 4, NITEMS = I_WIN + I_PP + I_PM + I_OUT + I_VB + I_QR; }
constexpr int LATE_CNT_WORD = 3712;
__device__ __forceinline__ void p0_late(const Params& P, unsigned char* lds, LAS unsigned char* ldsl, const int wave, volatile LAS unsigned* st) {
    using namespace p0i;
    unsigned char* ws = P.ws; const int lane = lane_id(), tid = wave * 64 + lane;
    constexpr int NLATE = NITEMS - I_WIN, NCH = 64 + (NLATE + NWAVES - 1) / NWAVES;
    LAS float* scr = (LAS float*)(ldsl + wave * 8448);
    unsigned* cnt = (unsigned*)(ws + WS_BAR) + LATE_CNT_WORD;
    for (;;) {
        if (tid == 0) st[3] = __hip_atomic_fetch_add(cnt, 1u, __ATOMIC_RELAXED, __HIP_MEMORY_SCOPE_AGENT);
        __syncthreads();
        const unsigned c = st[3];
        __syncthreads();
        if (c >= (unsigned)NCH) break;
        if (c < 64u) { wqt_role(P, (float*)lds, tid, 96 + (int)c); continue; }
        int r = ((int)c - 64) * NWAVES + wave; if (r >= NLATE) continue;
        if (r < I_PP) { tr_item(P.w_pp, 1024, 32, (bf16_t*)(ws + WS_WCAT), 3072, 0, 0, nullptr, r, scr, lane); continue; } r -= I_PP;
        if (r < I_PM) { tr_item(P.w_pm, 1024, 32, (bf16_t*)(ws + WS_WCAT), 3072, 1024, 0, nullptr, r, scr, lane); continue; } r -= I_PM;
        if (r < I_OUT) { tr_item(P.w_out, 1024, 32, (bf16_t*)(ws + WS_WOUT), 1024, 0, 0, nullptr, r, scr, lane); continue; } r -= I_OUT;
        if (r < I_VB) { tr_item(P.w_kvb, 4096, 64, (bf16_t*)(ws + WS_WVBT), 128, 0, 2, nullptr, r, scr, lane); continue; } r -= I_VB;
        tr_item(P.w_qb, 3072, 32, (bf16_t*)(ws + WS_WQT), 256, 0, 3, P.q_norm_g, r, scr, lane);
    }
}
__device__ __forceinline__ void p0_prep(const Params& P, unsigned char* lds, LAS unsigned char* ldsl, const int wave, const bool defer_late = false) {
    unsigned char* ws = P.ws; float* fl = (float*)lds;
    const int lane = lane_id(), tid = wave * 64 + lane, bid = blockIdx.x, G = gridDim.x;
    float* ADA = (float*)(ws + WS_ADA);
    if (bid < 96) {
        float* sl = fl;
        float* red = fl + 17 * 1024;
        const int j = bid * 32 + (lane & 31), kb = wave * 128 + (lane >> 5) * 64;
        f32x4 cv[9];
#pragma unroll
        for (int q = 0; q < 9; ++q) { const int i4 = tid + NTHREADS * q; const int r = i4 >> 8, k = (i4 & 255) * 4;
            cv[q] = (i4 < 17 * 256) ? *(const f32x4*)(r < 16 ? P.c + r * D + k : P.c_ctx + k) : (f32x4){0.f, 0.f, 0.f, 0.f}; }
#pragma unroll
        for (int q = 0; q < 9; ++q) { const int i4 = tid + NTHREADS * q;
            if (i4 < 17 * 256) { f32x4 o; for (int e = 0; e < 4; ++e) o[e] = siluf(cv[q][e]); *(f32x4*)(sl + i4 * 4) = o; } }
        float w[64];
        {
            const __amdgpu_buffer_rsrc_t wrs = __builtin_amdgcn_make_buffer_rsrc((void*)P.ada_w, 0, 1024 * 3072 * 4, 0x00020000);
            const int wo = (kb * 3072 + j) * 4;
#pragma unroll
            for (int i = 0; i < 64; ++i) w[i] = __builtin_bit_cast(float, __builtin_amdgcn_raw_buffer_load_b32(wrs, wo, i * 12288, 0));
        }
        __syncthreads();
        float acc[17];
#pragma unroll
        for (int r = 0; r < 17; ++r) acc[r] = 0.f;
#pragma unroll
        for (int i4 = 0; i4 < 16; ++i4) {
#pragma unroll
            for (int r = 0; r < 17; ++r) { const f32x4 sv = *(const f32x4*)(sl + r * 1024 + kb + 4 * i4);
                acc[r] += sv[0] * w[4 * i4] + sv[1] * w[4 * i4 + 1] + sv[2] * w[4 * i4 + 2] + sv[3] * w[4 * i4 + 3]; }
            asm volatile("" : "+v"(acc[0]), "+v"(acc[1]), "+v"(acc[2]), "+v"(acc[3]), "+v"(acc[4]), "+v"(acc[5]), "+v"(acc[6]), "+v"(acc[7]), "+v"(acc[8]), "+v"(acc[9]), "+v"(acc[10]), "+v"(acc[11]),
                         "+v"(acc[12]), "+v"(acc[13]), "+v"(acc[14]), "+v"(acc[15]), "+v"(acc[16]) :: "memory");
        }
#pragma unroll
        for (int r = 0; r < 17; ++r) { acc[r] = half_swap_sum(acc[r]); if (lane < 32) red[(wave * 17 + r) * 32 + lane] = acc[r]; }
        __syncthreads();
        for (int i = tid; i < 17 * 32; i += NTHREADS) { const int r = i >> 5, jj = i & 31; float s = 0.f;
            for (int w = 0; w < 8; ++w) s += red[(w * 17 + r) * 32 + jj];
            ADA[r * 3072 + bid * 32 + jj] = s + P.ada_b[bid * 32 + jj]; }
        asm volatile("s_waitcnt vmcnt(0)" ::: "memory"); __syncthreads();
        if (tid == 0) { __builtin_amdgcn_fence(__ATOMIC_RELEASE, "agent"); asm volatile("s_waitcnt vmcnt(0)" ::: "memory");
            __hip_atomic_fetch_add((unsigned*)(ws + WS_BAR) + ADA_CNT_WORD, 1u, __ATOMIC_RELAXED, __HIP_MEMORY_SCOPE_AGENT); }
    } else if (bid < 96 + 64) {
        if (!defer_late) wqt_role(P, fl, tid, bid);
    } else if (bid == 96 + 64) {
        float* rope = (float*)(ws + WS_ROPE);
        for (int i = tid; i < 64 * 16; i += NTHREADS) { const int pos = i >> 4, f = i & 15; const float a = (float)pos * powf(10000.f, -(float)f / 16.f); rope[i * 2] = cosf(a); rope[i * 2 + 1] = sinf(a); }
    }
    __syncthreads();
    {
        LAS float* scr = (LAS float*)(ldsl + wave * 8448);
        using namespace p0i;
        for (int it = bid * NWAVES + wave; it < (defer_late ? I_WIN : NITEMS); it += G * NWAVES) {
            int r = it;
            if (r < I_WIN) { tr_item(P.w_in, INW, (N1 - 1024) / 32, (bf16_t*)(ws + WS_WINT), 1024, 0, 1, nullptr, r, scr, lane); continue; } r -= I_WIN;
            if (r < I_PP) { tr_item(P.w_pp, 1024, 32, (bf16_t*)(ws + WS_WCAT), 3072, 0, 0, nullptr, r, scr, lane); continue; } r -= I_PP;
            if (r < I_PM) { tr_item(P.w_pm, 1024, 32, (bf16_t*)(ws + WS_WCAT), 3072, 1024, 0, nullptr, r, scr, lane); continue; } r -= I_PM;
            if (r < I_OUT) { tr_item(P.w_out, 1024, 32, (bf16_t*)(ws + WS_WOUT), 1024, 0, 0, nullptr, r, scr, lane); continue; } r -= I_OUT;
            if (r < I_VB) { tr_item(P.w_kvb, 4096, 64, (bf16_t*)(ws + WS_WVBT), 128, 0, 2, nullptr, r, scr, lane); continue; } r -= I_VB;
            tr_item(P.w_qb, 3072, 32, (bf16_t*)(ws + WS_WQT), 256, 0, 3, P.q_norm_g, r, scr, lane);
        }
        __syncthreads();
    }
    for (int it = (bid + G - 160 % G) % G; it < 256; it += G) {
        const int g = it >> 6, k0 = ((it >> 2) & 15) * 64, d0 = (it & 3) * 64;
        float* As = fl;
        float* Bs = fl + 64 * 257;
        {
            f32x4 av[8], bv[8];
#pragma unroll
            for (int q = 0; q < 8; ++q) { const int i4 = tid + NTHREADS * q, kk = i4 >> 6, c = (i4 & 63) * 4; av[q] = *(const f32x4*)(P.w_in + (size_t)(k0 + kk) * INW + g * 256 + c); }
#pragma unroll
            for (int q = 0; q < 8; ++q) { const int i4 = tid + NTHREADS * q, c = i4 >> 4, d = (i4 & 15) * 4; bv[q] = *(const f32x4*)(P.w_pool + ((size_t)g * 256 + c) * 256 + d0 + d); }
#pragma unroll
            for (int q = 0; q < 8; ++q) { const int i4 = tid + NTHREADS * q, kk = i4 >> 6, c = (i4 & 63) * 4; for (int e = 0; e < 4; ++e) As[kk * 257 + c + e] = av[q][e]; }
#pragma unroll
            for (int q = 0; q < 8; ++q) { const int i4 = tid + NTHREADS * q, c = i4 >> 4, d = (i4 & 15) * 4; *(f32x4*)(Bs + c * 64 + d) = bv[q]; }
        }
        __syncthreads();
        const int kk = tid & 63, db = tid >> 6;
        f32x4 a0 = {0.f, 0.f, 0.f, 0.f}, a1 = {0.f, 0.f, 0.f, 0.f};
#pragma unroll 8
        for (int c = 0; c < 256; ++c) { const float av = As[kk * 257 + c]; const f32x4 b0 = *(const f32x4*)(Bs + c * 64 + 8 * db), b1 = *(const f32x4*)(Bs + c * 64 + 8 * db + 4);
            a0 += b0 * av; a1 += b1 * av; }
#pragma unroll
        for (int i = 0; i < 4; ++i) { ((bf16_t*)(ws + WS_WINT))[((size_t)g * 256 + d0 + 8 * db + i) * 1024 + k0 + kk] = f2bf(a0[i]);
                                      ((bf16_t*)(ws + WS_WINT))[((size_t)g * 256 + d0 + 8 * db + 4 + i) * 1024 + k0 + kk] = f2bf(a1[i]); }
        __syncthreads();
    }
}

__device__ __forceinline__ void h_rows(const Params& P, const int lane, const int first, const int step, const int last  ) {
    const float* ADA = (const float*)(P.ws + WS_ADA); bf16_t* H = (bf16_t*)P.out;
    f32x4 g[4];
#pragma unroll
    for (int j = 0; j < 4; ++j) g[j] = *(const f32x4*)(P.norm_g + 256 * j + 4 * lane);
    for (int row0 = 4 * first; row0 < last; row0 += 4 * step) {
        f32x4 v[4][4], ma[4], mb[4]; float ss[4];
        const float* sh = ADA + (row0 < M ? row0 / S : 16) * 3072, *sc = sh + 1024;
#pragma unroll
        for (int u = 0; u < 4; ++u) { const int row = row0 + u; const float* src = row < M ? P.x + (size_t)row * D : P.ctx + (size_t)(row - M) * D; ss[u] = 0.f;
#pragma unroll
            for (int j = 0; j < 4; ++j) { v[u][j] = __builtin_nontemporal_load((const f32x4*)(src + 256 * j + 4 * lane)); ss[u] += v[u][j][0] * v[u][j][0] + v[u][j][1] * v[u][j][1] + v[u][j][2] * v[u][j][2] + v[u][j][3] * v[u][j][3]; } }
#pragma unroll
        for (int j = 0; j < 4; ++j) { const int c0 = 256 * j + 4 * lane; ma[j] = g[j] * (*(const f32x4*)(sc + c0) + 1.f); mb[j] = *(const f32x4*)(sh + c0); }
#pragma unroll
        for (int u = 0; u < 4; ++u) { const int row = row0 + u;
            const float rinv = rsqrtf(wave_sum(ss[u]) * (1.f / D) + EPS);
#pragma unroll
            for (int j = 0; j < 4; ++j) { const int c0 = 256 * j + 4 * lane;
                const f32x4 o = v[u][j] * rinv * ma[j] + mb[j]; const u32x2 w = cvt2_pk_bf16(o[0], o[1], o[2], o[3]);
                *(u32x2*)(H + (size_t)row * D + c0) = w; } }
    }
}
__device__ __forceinline__ void p1_h(const Params& P, const int wave) {
    const int lane = lane_id();
    {
        if (wave == 0) { unsigned* cnt = (unsigned*)(P.ws + WS_BAR) + ADA_CNT_WORD; unsigned sp = 0;
            while ((unsigned)__builtin_amdgcn_readfirstlane((int)__hip_atomic_load(cnt, __ATOMIC_RELAXED, __HIP_MEMORY_SCOPE_AGENT)) < 96u) { __builtin_amdgcn_s_sleep(2); if (++sp > (1u << 22)) break; }
            __builtin_amdgcn_fence(__ATOMIC_ACQUIRE, "agent"); asm volatile("s_waitcnt vmcnt(0)" ::: "memory"); }
        __syncthreads();
    }
    h_rows(P, lane, blockIdx.x * NWAVES + wave, gridDim.x * NWAVES, MT);
}

__device__ __forceinline__ f32x4 ld4bf(const bf16_t* p) { const u32x2 w = *(const u32x2*)p; return (f32x4){bflo(w.x), bfhi(w.x), bflo(w.y), bfhi(w.y)}; }
template <int HW>
__device__ __forceinline__ void pool_half(const char* UWc, const char* SGPc, char* CATc, unsigned uo  , unsigned co  , const int tl  , const f32x4 ps) {
    constexpr int NR = 16 + 2 * HW;
    asm volatile("" : "+v"(uo), "+v"(co));
    u32x2 ur[NR], sr[16];
#pragma unroll
    for (int r = 0; r < NR; ++r) { const int row = tl - HW + r; const bool ok = (unsigned)row < (unsigned)S; ur[r] = *(const u32x2*)(UWc + (uo + (unsigned)((ok ? r - HW : 0) * 2048))); }
#pragma unroll
    for (int k = 0; k < 16; ++k) sr[k] = *(const u32x2*)(SGPc + (uo + (unsigned)(k * 2048)));
    auto f4 = [](const u32x2 w) { return (f32x4){bflo(w.x), bfhi(w.x), bflo(w.y), bfhi(w.y)}; };
    f32x4 sum = {0.f, 0.f, 0.f, 0.f};
#pragma unroll
    for (int r = 0; r < 2 * HW; ++r) sum += f4(ur[r]) * (((unsigned)(tl - HW + r) < (unsigned)S) ? 1.f : 0.f);
#pragma unroll
    for (int k = 0; k < 16; ++k) {
        const int t = tl + k, lo = max(t - HW, 0), hi = min(t + HW, S);
        const f32x4 o = (sum * (1.f / (float)(hi - lo)) - f4(ur[k + HW])) * ps * f4(sr[k]);
        const u32x2 w = cvt2_pk_bf16(o[0], o[1], o[2], o[3]);
        *(u32x2*)(CATc + (co + (unsigned)(k * 6144))) = w;
        sum += f4(ur[k + 2 * HW]) * (((unsigned)(tl + HW + k) < (unsigned)S) ? 1.f : 0.f) - f4(ur[k]) * (((unsigned)(tl - HW + k) < (unsigned)S) ? 1.f : 0.f);
    }
}
template <class Epi>
__device__ __forceinline__ void p3_thin(const Params& P, const int wave, LAS unsigned char* ldsl, const bool split, const Epi& e1, const bool ctx_in_g1 = false, const int part = 3  ) {
    const int lane = lane_id(), bid = blockIdx.x, G = gridDim.x;
    const bool ctxwg = split && bid < MC / 256;
    const int nthin = split ? G - MC / 256 : G, gw = ((split ? bid - MC / 256 : bid) * NWAVES + wave), NGW = nthin * NWAVES;
    const float* KVA = (const float*)((const unsigned char*)P.out + OUT_KVA); const float* rope = (const float*)(P.ws + WS_ROPE); bf16_t* KC = (bf16_t*)(P.ws + WS_KC);
    if (ctxwg && (part & 1)) {
        asm volatile("s_waitcnt vmcnt(0)" ::: "memory"); __syncthreads();
        __builtin_amdgcn_fence(__ATOMIC_ACQUIRE, "agent"); asm volatile("s_waitcnt vmcnt(0)" ::: "memory"); __syncthreads();
    }
    const int l16 = lane & 15;
    const f32x4 g0 = *(const f32x4*)(P.kv_norm_g + 8 * l16), g1 = *(const f32x4*)(P.kv_norm_g + 8 * l16 + 4);
    const int kp_first = ctxwg ? (M + bid * 256) / 4 + wave : (split ? (gw < 0 ? 0 : gw) : gw), kp_step = ctxwg ? NWAVES : NGW, kp_last = !(part & 1) ? 0 : ctxwg ? (M + bid * 256 + 256) / 4 : (split ? M / 4 : MT / 4);
    constexpr int KPB = 8;
    for (int it0 = kp_first; it0 < kp_last; it0 += KPB * kp_step) {
        f32x4 c0[KPB] = {}, c1[KPB] = {}, kr[KPB] = {}, t0[KPB] = {}, t1[KPB] = {};
#pragma unroll
        for (int u = 0; u < KPB; ++u) {
            const int it = it0 + u * kp_step;
            if (it < kp_last) {
                const int t = it * 4 + (lane >> 4); const bool isx = t < M;
                const int pos = isx ? t % S : (t - M) % CTX;
                const float* src = KVA + (size_t)t * 256;
                c0[u] = *(const f32x4*)(src + 8 * l16); c1[u] = *(const f32x4*)(src + 8 * l16 + 4); kr[u] = *(const f32x4*)(src + 128 + 4 * l16);
                const int w8 = l16 & 7, pp = (l16 >= 8) ? (pos & 63) : (pos >> 6), i0 = 4 * (w8 & 3);
                if (isx) { t0[u] = *(const f32x4*)(rope + (pp * 16 + i0) * 2); t1[u] = *(const f32x4*)(rope + (pp * 16 + i0) * 2 + 4); }
            }
        }
#pragma unroll
        for (int u = 0; u < KPB; ++u) {
            const int it = it0 + u * kp_step;
            if (it < kp_last) {
                const int t = it * 4 + (lane >> 4); const bool isx = t < M;
                const int b = isx ? t / S : (t - M) / CTX, pos = isx ? t % S : (t - M) % CTX, key = isx ? pos : S + pos;
                const int w8 = l16 & 7;
                const f32x4 a0 = c0[u], a1 = c1[u]; f32x4 k4 = kr[u];
                float ss = a0[0] * a0[0] + a0[1] * a0[1] + a0[2] * a0[2] + a0[3] * a0[3] + a1[0] * a1[0] + a1[1] * a1[1] + a1[2] * a1[2] + a1[3] * a1[3];
                ss += swz_xor<1>(ss); ss += swz_xor<2>(ss); ss += swz_xor<4>(ss); ss += swz_xor<8>(ss);
                const float rinv = rsqrtf(ss * (1.f / KVL) + EPS);
                bf16_t* dst = KC + ((size_t)b * NKEY + key) * QKD;
                *(u32x4*)(dst + 8 * l16) = pg8::pack8(a0 * rinv * g0, a1 * rinv * g1);
                const f32x4 other = {swz_xor<4>(k4[0]), swz_xor<4>(k4[1]), swz_xor<4>(k4[2]), swz_xor<4>(k4[3])};
                if (isx) {
                    const f32x4 cs = {t0[u][0], t0[u][2], t1[u][0], t1[u][2]}, sn = {t0[u][1], t0[u][3], t1[u][1], t1[u][3]};
                    k4 = (w8 < 4) ? k4 * cs - other * sn : k4 * cs + other * sn;
                }
                const u32x2 o = cvt2_pk_bf16(k4[0], k4[1], k4[2], k4[3]);
                *(u32x2*)(dst + 128 + 4 * l16) = o;
            }
        }
    }
    const bf16_t* UW = (const bf16_t*)(P.ws + WS_U); const bf16_t* SGP = (const bf16_t*)(P.ws + WS_SGP); bf16_t* CAT = (bf16_t*)(P.ws + WS_CAT);
    for (int hit = (ctxwg || !(part & 2)) ? 2 * NB * 64 * 4 : gw; hit < 2 * NB * 64 * 4; hit += NGW) {
        const int it = hit >> 1;
        const int g = it & 3, ch = (it >> 2) & 63, bq = it >> 8, b = bq < NB / 2 ? 2 * bq : 2 * (bq - NB / 2) + 1, th = ch * 32 + (hit & 1) * 16, col = g * 256 + 4 * lane;
        const f32x4 ps = *(const f32x4*)(P.pool_scale + col);
        const unsigned uo = (unsigned)(((b * S + th) * 1024 + col) * 2), co = (unsigned)(((size_t)(b * S + th) * 3072 + col) * 2);
        if (g == 0) pool_half<1>((const char*)UW, (const char*)SGP, (char*)CAT, uo, co, th, ps); else if (g == 1) pool_half<2>((const char*)UW, (const char*)SGP, (char*)CAT, uo, co, th, ps);
        else if (g == 2) pool_half<4>((const char*)UW, (const char*)SGP, (char*)CAT, uo, co, th, ps); else pool_half<8>((const char*)UW, (const char*)SGP, (char*)CAT, uo, co, th, ps);
    }
}

namespace att {
using f32x16 = __attribute__((ext_vector_type(16))) float;
using s16x4  = __attribute__((ext_vector_type(4))) short;
constexpr float SCALE = 0.07216878364870322f;
constexpr float THR = 8.f;
constexpr float THRL = THR * 1.4426950408889634f;
constexpr int KVBLK = 64, NT = NKEY / KVBLK;
constexpr int T0_V = 104448, T0_K = T0_V + 16384;
constexpr int WPITCH = 528, VPITCH = 272;
constexpr int KROW = 384;
constexpr int SHM_V = KVBLK * 128 * 2, SHM_K = KVBLK * KROW, V_OFF = 0, K_OFF = 3 * SHM_V;
static_assert(NT % 2 == 0 && K_OFF + 2 * SHM_K <= 131072 && 192 * WPITCH <= 131072, "attention LDS map");
#define SBAR() __builtin_amdgcn_sched_barrier(0)
__device__ __forceinline__ int crow(int r, int hi) { return (r & 3) + 8 * (r >> 2) + 4 * hi; }
__device__ __forceinline__ bf16x8 pack8r(const f32x16& a, int base) {
    u32x4 w = cvt4_pk_bf16(a[base + 0], a[base + 1], a[base + 2], a[base + 3], a[base + 4], a[base + 5], a[base + 6], a[base + 7]);
    return *reinterpret_cast<bf16x8*>(&w);
}
constexpr float CL2 = SCALE * 1.4426950408889634f;
#define PK4(P, BASE, OUT) do { const u32x4 c_ = cvt4_pk_bf16(P[BASE + 0], P[BASE + 1], P[BASE + 2], P[BASE + 3], P[BASE + 4], P[BASE + 5], P[BASE + 6], P[BASE + 7]); \
    const unsigned a0_ = c_.x, a1_ = c_.y, b0_ = c_.z, b1_ = c_.w;                                                                  \
    auto r0_ = __builtin_amdgcn_permlane32_swap(a0_, b0_, false, false); auto r1_ = __builtin_amdgcn_permlane32_swap(a1_, b1_, false, false); \
    u32x4 w_ = {r0_[0], r1_[0], r0_[1], r1_[1]}; OUT = *reinterpret_cast<bf16x8*>(&w_); } while (0)
template <int OFF> __device__ __forceinline__ bf16x8 k_read(int ka) { bf16x8 r; asm volatile("ds_read_b128 %0, %1 offset:%2" : "=&v"(r) : "v"(ka), "i"(OFF) : "memory"); return r; }
#define LGKM(n) asm volatile("s_waitcnt lgkmcnt(" #n ")" ::: "memory")
template <int KB, bool FIN> __device__ __forceinline__ void qkt_fin(f32x16& n0, f32x16& n1, const f32x16& negm, const int (&ka)[4], const bf16x8* qr,
                                                                    f32x16& f0, f32x16& f1, const float al, float& l_reg, bf16x8& pa0, bf16x8& pa1, bf16x8& pa2, bf16x8& pa3) {
    constexpr int H1 = 32 * KROW;
    float ps0 = 0.f, ps1 = 0.f;
#define QSTEP(D, A0, A1, NW) LGKM(NW); SBAR(); n0 = __builtin_amdgcn_mfma_f32_32x32x16_bf16(A0, qr[D], n0, 0, 0, 0); n1 = __builtin_amdgcn_mfma_f32_32x32x16_bf16(A1, qr[D], n1, 0, 0, 0);
#define QLOAD(D, A0, A1) A0 = k_read<KB + ((D) >> 2) * 128>(ka[(D) & 3]); A1 = k_read<KB + H1 + ((D) >> 2) * 128>(ka[(D) & 3]);
#define FEXP(K) if constexpr (FIN) { _Pragma("unroll") for (int r_ = 4 * (K); r_ < 4 * (K) + 4; ++r_) f1[r_] = __builtin_amdgcn_exp2f(f1[r_]); }
#define FEXP0(K) if constexpr (FIN) { _Pragma("unroll") for (int r_ = 4 * (K); r_ < 4 * (K) + 4; ++r_) f0[r_] = __builtin_amdgcn_exp2f(f0[r_]); }
    bf16x8 a0, a1, b0, b1;
    QLOAD(0, a0, a1) QLOAD(1, b0, b1)
    LGKM(2); SBAR(); n0 = __builtin_amdgcn_mfma_f32_32x32x16_bf16(a0, qr[0], negm, 0, 0, 0); n1 = __builtin_amdgcn_mfma_f32_32x32x16_bf16(a1, qr[0], negm, 0, 0, 0);
    QLOAD(2, a0, a1) FEXP(0)
    QSTEP(1, b0, b1, 2) QLOAD(3, b0, b1) FEXP(1)
    QSTEP(2, a0, a1, 2) QLOAD(4, a0, a1) FEXP(2)
    QSTEP(3, b0, b1, 2) QLOAD(5, b0, b1) FEXP(3)
    QSTEP(4, a0, a1, 2) QLOAD(6, a0, a1) FEXP0(2)
    QSTEP(5, b0, b1, 2) QLOAD(7, b0, b1) FEXP0(3)
    QSTEP(6, a0, a1, 2) QLOAD(8, a0, a1)
    if constexpr (FIN) {
#pragma unroll
        for (int r = 0; r < 16; ++r) ps0 += f0[r]; }
    QSTEP(7, b0, b1, 2) QLOAD(9, b0, b1)
    if constexpr (FIN) {
#pragma unroll
        for (int r = 0; r < 16; ++r) ps1 += f1[r]; }
    QSTEP(8, a0, a1, 2) QLOAD(10, a0, a1)
    if constexpr (FIN) { float ps = ps0 + ps1; ps = half_swap_sum(ps); l_reg = l_reg * al + ps; PK4(f0, 0, pa0); }
    QSTEP(9, b0, b1, 2) QLOAD(11, b0, b1)
    if constexpr (FIN) { PK4(f0, 8, pa1); }
    QSTEP(10, a0, a1, 2)
    if constexpr (FIN) { PK4(f1, 0, pa2); }
    QSTEP(11, b0, b1, 0)
    if constexpr (FIN) { PK4(f1, 8, pa3); }
    SBAR();
#undef QSTEP
#undef QLOAD
#undef FEXP
#undef FEXP0
}
__device__ __forceinline__ void finishSM(f32x16& f0, f32x16& f1, const float al, float& l_reg, bf16x8& pa0, bf16x8& pa1, bf16x8& pa2, bf16x8& pa3) {
#pragma unroll
    for (int r = 0; r < 16; ++r) f1[r] = __builtin_amdgcn_exp2f(f1[r]);
#pragma unroll
    for (int r = 8; r < 16; ++r) f0[r] = __builtin_amdgcn_exp2f(f0[r]);
    float ps = 0.f;
#pragma unroll
    for (int r = 0; r < 16; ++r) ps += f0[r];
#pragma unroll
    for (int r = 0; r < 16; ++r) ps += f1[r];
    ps = half_swap_sum(ps); l_reg = l_reg * al + ps;
    PK4(f0, 0, pa0); PK4(f0, 8, pa1); PK4(f1, 0, pa2); PK4(f1, 8, pa3);
}
__device__ __forceinline__ float sm_rowmax(const f32x16& s0, const f32x16& s1) {
    float pmax = s0[0];
#pragma unroll
    for (int r = 1; r < 16; ++r) pmax = fmaxf(pmax, s0[r]);
#pragma unroll
    for (int r = 0; r < 16; ++r) pmax = fmaxf(pmax, s1[r]);
    return half_swap_max(pmax);
}
#define SM_UPDATE(s0, s1, pmax, negm, alpha) do { alpha = 1.f; if (!__all((pmax) <= THRL)) { const float dl_ = fmaxf((pmax), 0.f); alpha = __builtin_amdgcn_exp2f(-dl_); \
        _Pragma("unroll") for (int r_ = 0; r_ < 16; ++r_) { s0[r_] -= dl_; s1[r_] -= dl_; negm[r_] -= dl_; } } } while (0)
__device__ __forceinline__ void partialSM_first(f32x16& s0, f32x16& s1, f32x16& negm, float& alpha) {
    const float m0 = sm_rowmax(s0, s1); alpha = 1.f;
#pragma unroll
    for (int r = 0; r < 16; ++r) { s0[r] -= m0; s1[r] -= m0; negm[r] = -m0; }
#pragma unroll
    for (int r = 0; r < 8; ++r) s0[r] = __builtin_amdgcn_exp2f(s0[r]);
}
__device__ __forceinline__ int v_st(int k, int c) { const int kk = (k & ~0xC) | ((k & 4) << 1) | ((k & 8) >> 1); return ((kk >> 3) * 4 + (c >> 5)) * 512 + ((kk & 7) * 32 + (c & 31)) * 2; }
__device__ __forceinline__ int v_rd_base(int lane) { return ((lane & 3) << 3) | (((lane >> 2) & 3) << 6) | (((lane >> 4) & 1) << 5) | (((lane >> 5) & 1) << 8); }
constexpr int v_rd_off(int d0, int ks, int half) { return d0 * 512 + ks * 4096 + half * 2048; }
template <int OFF> __device__ __forceinline__ s16x4 tr_read(int vb) {
    s16x4 r; asm volatile("ds_read_b64_tr_b16 %0, %1 offset:%2" : "=&v"(r) : "v"(vb), "i"(OFF) : "memory"); return r;
}
struct VF { s16x4 l0, h0, l1, h1, l2, h2, l3, h3; };
template <int VB, int D0> __device__ __forceinline__ void v_load(VF& f, int vb) {
    f.l0 = tr_read<VB + v_rd_off(D0, 0, 0)>(vb); f.h0 = tr_read<VB + v_rd_off(D0, 0, 1)>(vb); f.l1 = tr_read<VB + v_rd_off(D0, 1, 0)>(vb); f.h1 = tr_read<VB + v_rd_off(D0, 1, 1)>(vb);
    f.l2 = tr_read<VB + v_rd_off(D0, 2, 0)>(vb); f.h2 = tr_read<VB + v_rd_off(D0, 2, 1)>(vb); f.l3 = tr_read<VB + v_rd_off(D0, 3, 0)>(vb); f.h3 = tr_read<VB + v_rd_off(D0, 3, 1)>(vb);
}
__device__ __forceinline__ void v_mma(f32x16& od, const VF& f, bf16x8 pa0, bf16x8 pa1, bf16x8 pa2, bf16x8 pa3) {
#define PK(L, H) (bf16x8){L[0], L[1], L[2], L[3], H[0], H[1], H[2], H[3]}
    od = __builtin_amdgcn_mfma_f32_32x32x16_bf16(PK(f.l0, f.h0), pa0, od, 0, 0, 0);
    od = __builtin_amdgcn_mfma_f32_32x32x16_bf16(PK(f.l1, f.h1), pa1, od, 0, 0, 0);
    od = __builtin_amdgcn_mfma_f32_32x32x16_bf16(PK(f.l2, f.h2), pa2, od, 0, 0, 0);
    od = __builtin_amdgcn_mfma_f32_32x32x16_bf16(PK(f.l3, f.h3), pa3, od, 0, 0, 0);
#undef PK
}
template <bool PART> __device__ __forceinline__ void v_mma_exp(f32x16& od, const VF& f, bf16x8 pa0, bf16x8 pa1, bf16x8 pa2, bf16x8 pa3, f32x16& s, const int base) {
#define PK(L, H) (bf16x8){L[0], L[1], L[2], L[3], H[0], H[1], H[2], H[3]}
#define EX1(i) if constexpr (PART) { float e_ = __builtin_amdgcn_exp2f(s[base + (i)]); asm volatile("" : "+v"(e_)); s[base + (i)] = e_; }
    od = __builtin_amdgcn_mfma_f32_32x32x16_bf16(PK(f.l0, f.h0), pa0, od, 0, 0, 0); EX1(0)
    od = __builtin_amdgcn_mfma_f32_32x32x16_bf16(PK(f.l1, f.h1), pa1, od, 0, 0, 0); EX1(1)
    od = __builtin_amdgcn_mfma_f32_32x32x16_bf16(PK(f.l2, f.h2), pa2, od, 0, 0, 0); EX1(2)
    od = __builtin_amdgcn_mfma_f32_32x32x16_bf16(PK(f.l3, f.h3), pa3, od, 0, 0, 0); EX1(3)
#undef EX1
#undef PK
}
template <int VB, bool PART> __device__ __forceinline__ void pv_part(f32x16* o, int vb, bf16x8 pa0, bf16x8 pa1, bf16x8 pa2, bf16x8 pa3,
                                                                     f32x16& s0, f32x16& s1, f32x16& negm, float& alpha) {
    VF fa, fb; float pmax = 0.f;
    v_load<VB, 0>(fa, vb); v_load<VB, 1>(fb, vb);
    LGKM(8); SBAR(); v_mma(o[0], fa, pa0, pa1, pa2, pa3); v_load<VB, 2>(fa, vb);
    if constexpr (PART) pmax = sm_rowmax(s0, s1);
    LGKM(8); SBAR(); v_mma(o[1], fb, pa0, pa1, pa2, pa3); v_load<VB, 3>(fb, vb);
    if constexpr (PART) { SM_UPDATE(s0, s1, pmax, negm, alpha); }
    LGKM(8); SBAR(); v_mma_exp<PART>(o[2], fa, pa0, pa1, pa2, pa3, s0, 0);
    LGKM(0); SBAR(); v_mma_exp<PART>(o[3], fb, pa0, pa1, pa2, pa3, s0, 4);
    SBAR();
}

__device__ __forceinline__ void attn_unit(const bf16_t* __restrict__ QAu, const bf16_t* __restrict__ WqTh, const bf16_t* __restrict__ Kb, const bf16_t* __restrict__ WvbPh,
                                          const float* __restrict__ rope, bf16_t* __restrict__ A2u, const int pos0, LAS unsigned char* lds, const int wid, const bool newb) {
    const int lane = lane_id(), tid = wid * 64 + lane, r32 = lane & 31, hi = lane >> 5;
    LAS unsigned char* V_lds = lds + V_OFF; LAS unsigned char* K_lds = lds + K_OFF;
    int ka[4];
    { const int sw = (r32 >> 1) & 7;
#pragma unroll
      for (int q = 0; q < 4; ++q) ka[q] = (int)(unsigned)(uintptr_t)K_lds + r32 * KROW + (((2 * q + hi) ^ sw) << 4); }
    const int vb0 = (int)(unsigned)(uintptr_t)V_lds + v_rd_base(lane);
    int ko[3], vo[2];
#pragma unroll
    for (int i = 0; i < 3; ++i) { const int L = (wid * 3 + i) * 64 + lane, row = L / 24, cp = L % 24, c = (cp & ~7) | ((cp & 7) ^ ((row >> 1) & 7)); ko[i] = row * KROW + c * 16; }
#pragma unroll
    for (int i = 0; i < 2; ++i) { const int B = ((wid * 2 + i) * 64 + lane) * 16, sub = B >> 9, w = (B & 511) >> 1, kk = (sub >> 2) * 8 + (w >> 5);
        const int k = (kk & ~0xC) | ((kk & 4) << 1) | ((kk & 8) >> 1), col = (sub & 3) * 32 + (w & 31); vo[i] = k * KROW + col * 2; }
    const __amdgpu_buffer_rsrc_t krs = __builtin_amdgcn_make_buffer_rsrc((void*)Kb, 0, NKEY * QKD * 2, 0x00020000);
#define DMAK(tile, kb) do { const int so_ = (tile) * (KVBLK * KROW);                                                                                             \
        _Pragma("unroll") for (int i_ = 0; i_ < 3; ++i_) __builtin_amdgcn_raw_ptr_buffer_load_lds(krs, (LAS void*)(K_lds + (kb) * SHM_K + (wid * 3 + i_) * 1024), 16, ko[i_], so_, 0, 0); } while (0)
#define DMAV(tile, voff) do { const int so_ = (tile) * (KVBLK * KROW);                                                                                           \
        _Pragma("unroll") for (int i_ = 0; i_ < 2; ++i_) __builtin_amdgcn_raw_ptr_buffer_load_lds(krs, (LAS void*)(V_lds + (voff) + (wid * 2 + i_) * 1024), 16, vo[i_], so_, 0, 0); } while (0)
#define DMA(tile, kb, voff) do { DMAK(tile, kb); DMAV(tile, voff); } while (0)
    if (newb) {
#pragma unroll
        for (int i_ = 0; i_ < 3; ++i_) __builtin_amdgcn_raw_ptr_buffer_load_lds(krs, (LAS void*)(lds + T0_K + (wid * 3 + i_) * 1024), 16, ko[i_], 0, 0, 0);
#pragma unroll
        for (int i_ = 0; i_ < 2; ++i_) __builtin_amdgcn_raw_ptr_buffer_load_lds(krs, (LAS void*)(lds + T0_V + (wid * 2 + i_) * 1024), 16, vo[i_], 0, 0, 0);
    }
    bf16x8 qr[12];
    { AT_BEGIN(2)
        bf16x8 qb[16]; float ss = 0.f;
        const bf16_t* qrow = QAu + (size_t)wid * 8192 + r32 * 16 + hi * 8;
#pragma unroll
        for (int kk = 0; kk < 16; ++kk) qb[kk] = *(const bf16x8*)(qrow + kk * 512);
#pragma unroll
        for (int kk = 0; kk < 16; ++kk)
#pragma unroll
            for (int j = 0; j < 8; ++j) { const float v = bf2f((bf16_t)qb[kk][j]); ss += v * v; }
        ss = half_swap_sum(ss);
        const float rinv = rsqrtf(ss * (1.f / QL) + EPS);
        const int rsw = (r32 & ~0xC) | ((r32 & 4) << 1) | ((r32 & 8) >> 1);
        const int pos = pos0 + wid * 32 + r32;
        unsigned t16 = (unsigned)tid * 16u; asm volatile("" : "+v"(t16));
        const int wdst = (int)(t16 >> 9) * WPITCH + (int)(t16 & 511u);
        {
            bf16x8 wv[12];
#pragma unroll
            for (int i = 0; i < 12; ++i) wv[i] = *(const bf16x8*)((const char*)WqTh + i * 8192 + t16);
#pragma unroll
            for (int i = 0; i < 12; ++i) *(LAS bf16x8*)(lds + i * 16 * WPITCH + wdst) = wv[i];
        }
        __syncthreads();
        const LAS unsigned char* wl = lds + rsw * WPITCH + hi * 16;
        f32x16 qacc[6];
#pragma unroll
        for (int t = 0; t < 6; ++t) {
            qacc[t] = f32x16{};
#pragma unroll
            for (int kk = 0; kk < 16; ++kk) { const bf16x8 a = *(const LAS bf16x8*)(wl + t * 32 * WPITCH + kk * 32); qacc[t] = __builtin_amdgcn_mfma_f32_32x32x16_bf16(a, qb[kk], qacc[t], 0, 0, 0); }
        }
#pragma unroll
        for (int t = 0; t < 6; ++t) {
            f32x16 acc = qacc[t];
#pragma unroll
            for (int r = 0; r < 16; ++r) acc[r] *= rinv * CL2;
            if (t >= 4) {
                const int pp = (t == 4) ? (pos >> 6) : (pos & 63);
#pragma unroll
                for (int r = 0; r < 8; ++r) { const float2 cs = *(const float2*)(rope + (pp * 16 + 8 * hi + r) * 2);
                    const float x1 = acc[r], x2 = acc[r + 8]; acc[r] = x1 * cs.x - x2 * cs.y; acc[r + 8] = x2 * cs.x + x1 * cs.y; }
            }
            qr[2 * t] = pack8r(acc, 0); qr[2 * t + 1] = pack8r(acc, 8);
        }
      AT_END(2)
    }
#define RESC(a) do { if (__any((a) < 1.f)) { _Pragma("unroll") for (int d = 0; d < 4; ++d) _Pragma("unroll") for (int r = 0; r < 16; ++r) o[d][r] *= (a); } } while (0)
    float l_reg = 0.f; f32x16 o[4] = {}; f32x16 negm = {};
    { AT_BEGIN(1)
    f32x16 pA0, pA1, pB0, pB1; float alA, alB; bf16x8 pa0, pa1, pa2, pa3;
#define TBAR2() do { asm volatile("s_waitcnt vmcnt(2) lgkmcnt(0)" ::: "memory"); __builtin_amdgcn_s_barrier(); } while (0)
#define VNEXT(R) ((R) == 2 * SHM_V ? 0 : (R) + SHM_V)
#define VWRITE(R) ((R) >= SHM_V ? (R) - SHM_V : (R) + 2 * SHM_V)
    __syncthreads();
    DMA(1, 1, SHM_V);
    { int ka0[4];
#pragma unroll
      for (int q = 0; q < 4; ++q) ka0[q] = ka[q] + (T0_K - K_OFF);
      qkt_fin<0, false>(pA0, pA1, negm, ka0, qr, pB0, pB1, 1.f, l_reg, pa0, pa1, pa2, pa3); }
    partialSM_first(pA0, pA1, negm, alA);
    __syncthreads();
    int R = 0, Rrd = T0_V - V_OFF;
    for (int j = 1; j + 1 < NT; j += 2) {
        DMAK(j + 1, 0);
        SBAR(); qkt_fin<SHM_K, true>(pB0, pB1, negm, ka, qr, pA0, pA1, alA, l_reg, pa0, pa1, pa2, pa3);
        pv_part<0, true>(o, vb0 + Rrd, pa0, pa1, pa2, pa3, pB0, pB1, negm, alB);
        DMAV(j + 1, VWRITE(R)); RESC(alB); TBAR2(); R = VNEXT(R); Rrd = R;
        DMAK(j + 2, 1);
        SBAR(); qkt_fin<0, true>(pA0, pA1, negm, ka, qr, pB0, pB1, alB, l_reg, pa0, pa1, pa2, pa3);
        pv_part<0, true>(o, vb0 + R, pa0, pa1, pa2, pa3, pA0, pA1, negm, alA);
        DMAV(j + 2, VWRITE(R)); RESC(alA); TBAR2(); R = VNEXT(R); Rrd = R;
    }
    __syncthreads();
    SBAR(); qkt_fin<SHM_K, true>(pB0, pB1, negm, ka, qr, pA0, pA1, alA, l_reg, pa0, pa1, pa2, pa3);
    pv_part<0, true>(o, vb0 + R, pa0, pa1, pa2, pa3, pB0, pB1, negm, alB);
    RESC(alB); R = VNEXT(R);
    finishSM(pB0, pB1, alB, l_reg, pa0, pa1, pa2, pa3); SBAR();
    pv_part<0, false>(o, vb0 + R, pa0, pa1, pa2, pa3, pB0, pB1, negm, alB);
    AT_END(1) }
#undef VNEXT
#undef VWRITE
#undef DMA
#undef DMAK
#undef DMAV
#undef TBAR2
#undef RESC
    int r32e = r32, hie = hi; asm volatile("" : "+v"(r32e), "+v"(hie));
    bf16_t* arow = A2u + (size_t)(wid * 32 + r32e) * 3072 + 8 * hie;
    u32x4 gq[8];
#pragma unroll
    for (int i = 0; i < 8; ++i) gq[i] = *(const u32x4*)(arow + 16 * i);
    __syncthreads();
    {
        bf16x8 wv[4];
        unsigned t16 = (unsigned)tid * 16u; asm volatile("" : "+v"(t16));
        const int vdst = (int)(t16 >> 8) * VPITCH + (int)(t16 & 255u);
#pragma unroll
        for (int i = 0; i < 4; ++i) wv[i] = *(const bf16x8*)((const char*)WvbPh + i * 8192 + t16);
#pragma unroll
        for (int i = 0; i < 4; ++i) *(LAS bf16x8*)(lds + i * 32 * VPITCH + vdst) = wv[i];
    }
    const float rl = __builtin_amdgcn_rcpf(l_reg);
    bf16x8 ob[8];
#pragma unroll
    for (int d = 0; d < 4; ++d) {
#pragma unroll
        for (int r = 0; r < 16; ++r) o[d][r] *= rl;
        ob[2 * d] = pack8r(o[d], 0); ob[2 * d + 1] = pack8r(o[d], 8); }
    __syncthreads();
    const LAS unsigned char* vl = lds + r32e * VPITCH + hie * 16;
#pragma unroll
    for (int vt = 0; vt < 4; ++vt) {
        f32x16 at = {};
#pragma unroll
        for (int ks = 0; ks < 8; ++ks) { const bf16x8 a = *(const LAS bf16x8*)(vl + vt * 32 * VPITCH + ks * 32); at = __builtin_amdgcn_mfma_f32_32x32x16_bf16(a, ob[ks], at, 0, 0, 0); }
#pragma unroll
        for (int gp = 0; gp < 2; ++gp) { const u32x4 L = gq[vt * 2 + gp];
            auto q0 = __builtin_amdgcn_permlane32_swap(L.x, L.z, false, false); auto q1 = __builtin_amdgcn_permlane32_swap(L.y, L.w, false, false);
            const int r0 = 8 * gp;
            u32x2 a, b;
            { const u32x4 c_ = cvt4_pk_bf16(at[r0 + 0] * bflo(q0[0]), at[r0 + 1] * bfhi(q0[0]), at[r0 + 2] * bflo(q1[0]), at[r0 + 3] * bfhi(q1[0]),
                                             at[r0 + 4] * bflo(q0[1]), at[r0 + 5] * bfhi(q0[1]), at[r0 + 6] * bflo(q1[1]), at[r0 + 7] * bfhi(q1[1]));
              a.x = c_.x; a.y = c_.y; b.x = c_.z; b.y = c_.w; }
            auto s0 = __builtin_amdgcn_permlane32_swap(a.x, b.x, false, false); auto s1 = __builtin_amdgcn_permlane32_swap(a.y, b.y, false, false);
            *(u32x4*)(arow + 16 * (vt * 2 + gp)) = (u32x4){s0[0], s1[0], s0[1], s1[1]}; }
    }
    __syncthreads();
}
#undef SBAR
#undef LGKM
#undef PK4
}

__device__ __forceinline__ void p5_attn(const Params& P, LAS unsigned char* lds, const int wid) {
    const int G = gridDim.x, c = blockIdx.x;
    const bf16_t* QA = (const bf16_t*)(P.ws + WS_QA); const bf16_t* WqT = (const bf16_t*)(P.ws + WS_WQT); const bf16_t* KC = (const bf16_t*)(P.ws + WS_KC);
    const bf16_t* WvbP = (const bf16_t*)(P.ws + WS_WVBT); const float* rope = (const float*)(P.ws + WS_ROPE); bf16_t* A2 = (bf16_t*)(P.ws + WS_CAT);
    constexpr int NU = NB * NH * (S / 256);
    int prevb = -1;
    for (int i = 0; ; ++i) {
        const int L = i * G + c; if (L >= NU) break;
        int b, h, qt;
        if (G == 256) { const int x = c & 7, loc = (i & 3) * 32 + (c >> 3); b = 2 * x + (i >> 2); h = loc >> 3; qt = loc & 7; }
        else { b = L / (NH * 8); h = (L >> 3) % NH; qt = L & 7; }
        const int tok0 = b * S + qt * 256;
        att::attn_unit(QA + (size_t)tok0 * QL, WqT + (size_t)h * QKD * QL, KC + (size_t)b * NKEY * QKD, WvbP + (size_t)h * VD * KVL, rope,
                       A2 + (size_t)tok0 * 3072 + 1024 + h * VD, qt * 256, lds, wid, b != prevb);
        prevb = b;
    }
}

__device__ __forceinline__ void p8_final(const Params& P, const int wave) {
    const int lane = lane_id(), gw = blockIdx.x * NWAVES + wave, NGW = gridDim.x * NWAVES;
    const bf16_t* GY = (const bf16_t*)(P.ws + WS_U);
    f32x4 g[4];
#pragma unroll
    for (int j = 0; j < 4; ++j) g[j] = *(const f32x4*)(P.final_g + 256 * j + 4 * lane);
    for (int row0 = 4 * gw; row0 < M; row0 += 4 * NGW) {
        f32x4 v[4][4]; float ss[4];
#pragma unroll
        for (int u = 0; u < 4; ++u) { const int row = row0 + u; const float* px = P.x + (size_t)row * D; const bf16_t* pg = GY + (size_t)row * D; ss[u] = 0.f;
#pragma unroll
            for (int j = 0; j < 4; ++j) { v[u][j] = __builtin_nontemporal_load((const f32x4*)(px + 256 * j + 4 * lane)) + ld4bf(pg + 256 * j + 4 * lane);
                ss[u] += v[u][j][0] * v[u][j][0] + v[u][j][1] * v[u][j][1] + v[u][j][2] * v[u][j][2] + v[u][j][3] * v[u][j][3]; } }
#pragma unroll
        for (int u = 0; u < 4; ++u) { float* p = P.out + (size_t)(row0 + u) * D; const float rinv = rsqrtf(wave_sum(ss[u]) * (1.f / D) + EPS);
#pragma unroll
            for (int j = 0; j < 4; ++j) __builtin_nontemporal_store(v[u][j] * rinv * g[j], (f32x4*)(p + 256 * j + 4 * lane)); }
    }
}

#ifndef PROBE_MASK
#define PROBE_MASK 0
#endif
#ifndef PROBE_ATTN
#define PROBE_ATTN 0
#endif
#define PH_BEGIN(k) unsigned long long t0_##k = 0; if ((PROBE_MASK >> (k)) & 1) t0_##k = __builtin_amdgcn_s_memrealtime();
#define PH_END(k) if ((PROBE_MASK >> (k)) & 1) { const unsigned long long t1_ = __builtin_amdgcn_s_memrealtime(); while (__builtin_amdgcn_s_memrealtime() - t1_ < t1_ - t0_##k) __builtin_amdgcn_s_sleep(16); }
__global__ void __launch_bounds__(NTHREADS, 2) fwd_megakernel(Params P) {
    extern __shared__ __attribute__((aligned(16))) unsigned char lds[];
    cg::grid_group grid = cg::this_grid();
    LAS unsigned char* ldsl = (LAS unsigned char*)lds;
    unsigned char* ws = P.ws; const int G = gridDim.x, bid = blockIdx.x, wid = __builtin_amdgcn_readfirstlane(threadIdx.x >> 6);
    bf16_t* WINT = (bf16_t*)(ws + WS_WINT); bf16_t* WCAT = (bf16_t*)(ws + WS_WCAT); bf16_t* WOUT = (bf16_t*)(ws + WS_WOUT);
    bf16_t* UW = (bf16_t*)(ws + WS_U); bf16_t* SGP = (bf16_t*)(ws + WS_SGP); bf16_t* CAT = (bf16_t*)(ws + WS_CAT); bf16_t* QA = (bf16_t*)(ws + WS_QA);
    bf16_t* GMP = (bf16_t*)(ws + WS_GMP); bf16_t* GMM = (bf16_t*)(ws + WS_GMM); float* KVA = (float*)((unsigned char*)P.out + OUT_KVA);
    bf16_t* H = (bf16_t*)P.out; bf16_t* Z = SGP;
    volatile LAS unsigned* st = (volatile LAS unsigned*)(ldsl + LDS_BYTES - 16);
    if (threadIdx.x < 4) st[threadIdx.x] = 0u;
    __syncthreads();
    XcdBarrier xb; xb.bar = (unsigned*)(ws + WS_BAR); xb.x = xb_xcc_id(); xb.st = st;
    if (threadIdx.x == 0) (void)xb_add(&xb.bar[XB_XCNT(xb.x)], 1u);
#define GRID_BAR() xcd_barrier(xb, wid)
    PH_BEGIN(0) p0_prep(P, lds, ldsl, wid, gridDim.x == 256); PH_END(0)
    if (P.ws == nullptr) grid.sync();
    const bool early = (G == 256);
    const bool split = false;
    pg8::Epi1 e1{UW, SGP, QA, CAT, GMP, GMM, KVA, P.b_gate};
    PH_BEGIN(1) p1_h(P, wid); PH_END(1)
    if (early) {
        asm volatile("s_waitcnt vmcnt(0)" ::: "memory"); __syncthreads();
        xcd_barrier_arrive_only(xb, wid == 0 && lane_id() == 0);
        p0_late(P, lds, ldsl, wid, st);
        xcd_barrier_finish(xb, wid);
    } else GRID_BAR();
    PH_BEGIN(2)
    {
        pg8::Gemm g{H, WINT, 1024, 1024, 1024, 0}; pg8::StaticOrder so; so.init(M / 256, N1 / 256, G, bid, split ? 0 : MC / 256); so.late8 = (G == 256);
        if (early && bid < MC / 256) { so.arrive_ui = 12; so.xb = xb; }
        pg8::gemm_phase(ldsl, g, so, e1, wid);
    }
    PH_END(2)
    if (!(early && bid < MC / 256)) GRID_BAR();
    if (early) {
        PH_BEGIN(3) p3_thin(P, wid, ldsl, true, e1, true, 1);
        if (bid < MC / 256) xcd_barrier_finish(xb, wid);
        asm volatile("s_waitcnt vmcnt(0)" ::: "memory"); __syncthreads();
        xcd_barrier_arrive_only(xb, wid == 0 && lane_id() == 0);
        p3_thin(P, wid, ldsl, true, e1, true, 2); PH_END(3)
        xcd_barrier_finish(xb, wid);
    } else {
        PH_BEGIN(3) p3_thin(P, wid, ldsl, split, e1, false); PH_END(3)
        GRID_BAR();
    }
    PH_BEGIN(5) p5_attn(P, ldsl, wid); PH_END(5)
    GRID_BAR();
    PH_BEGIN(6)
    {
        pg8::Gemm g{CAT, WCAT, 3072, 3072, 3072, 0}; pg8::StaticOrder so; so.init(M / 256, 4, G, bid, 0); so.rev2 = true;
        pg8::Epi3 e{GMM, Z};
        pg8::Hook3<true> hk{GMP, GMM}; pg8::gemm_phase(ldsl, g, so, e, wid, hk);
    }
    PH_END(6)
    GRID_BAR();
    PH_BEGIN(7)
    {
        pg8::Gemm g{Z, WOUT, 1024, 1024, 1024, 0}; pg8::StaticOrder so; so.init(M / 256, 4, G, bid, 0);
        pg8::Epi4 e{(const float*)(ws + WS_ADA), UW};
        pg8::gemm_phase(ldsl, g, so, e, wid);
    }
    PH_END(7)
    GRID_BAR();
    PH_BEGIN(8) p8_final(P, wid); PH_END(8)
}

extern "C" void kernel_launch(void* const* d_in, const int* in_sizes, int n_in, void* d_out, int out_size, void* d_ws, size_t ws_size, hipStream_t stream) {
    static int grid_blocks = 0;
    if (grid_blocks == 0) {
        if (n_in != 19 || out_size != M * D || ws_size < WS_END) { fprintf(stderr, "kernel_launch: unexpected shapes (n_in %d out %d ws %zu need %zu)\n", n_in, out_size, ws_size, (size_t)WS_END); grid_blocks = -1; return; }
        int dev = 0, cus = 0, per_cu = 0;
        (void)hipGetDevice(&dev); (void)hipDeviceGetAttribute(&cus, hipDeviceAttributeMultiprocessorCount, dev);
        if (hipFuncSetAttribute((const void*)fwd_megakernel, hipFuncAttributeMaxDynamicSharedMemorySize, LDS_BYTES) != hipSuccess) { fprintf(stderr, "kernel_launch: hipFuncSetAttribute failed\n"); grid_blocks = -1; return; }
        if (hipOccupancyMaxActiveBlocksPerMultiprocessor(&per_cu, (const void*)fwd_megakernel, NTHREADS, LDS_BYTES) != hipSuccess || per_cu < 1) { fprintf(stderr, "kernel_launch: occupancy query failed (%d)\n", per_cu); grid_blocks = -1; return; }
        grid_blocks = cus * 1;
        fprintf(stderr, "kernel_launch: cus %d per_cu %d grid %d\n", cus, per_cu, grid_blocks);
    }
    if (grid_blocks < 0) return;
    Params p{};
    const float** pf = (const float**)&p;
    for (int i = 0; i < 19; ++i) pf[i] = (const float*)d_in[i];
    p.out = (float*)d_out; p.ws = (unsigned char*)d_ws;
    if (hipMemsetAsync((char*)d_ws + WS_BAR, 0, BAR_BYTES, stream) != hipSuccess) { fprintf(stderr, "kernel_launch: memset failed\n"); return; }
    void* args[] = {&p};
    hipError_t e = hipLaunchCooperativeKernel((const void*)fwd_megakernel, dim3(grid_blocks), dim3(NTHREADS), args, LDS_BYTES, stream);
    if (e != hipSuccess) fprintf(stderr, "kernel_launch: cooperative launch failed: %s (grid %d)\n", hipGetErrorString(e), grid_blocks);
}
```
